# Optimizing an MI355X kernel written in HIP

```python
import math
import jax, jax.numpy as jnp
from jax import lax
import numpy as np

D_MODEL = 2048
BATCH = 2
SEQ = 4096
DEPTH = 2

N_GROUPS = 4
GROUP_W = D_MODEL // N_GROUPS
D_MIX = N_GROUPS * GROUP_W
N_IN_BLOCKS = 15
CONV_W = 3
HG_HEADS = 4
HG_DK = GROUP_W // HG_HEADS
HG_CHUNK = 64
F_FLOOR = 1e-30
DA_HEADS = 4
DA_DV = GROUP_W // DA_HEADS
DA_DQK = DA_DV // 2
Q_BLOCK = 128
MASK_VALUE = -1e30
SG_CHUNK = 128
SG_GROUPS = 4
SG_CH = GROUP_W // SG_GROUPS
PLE_DIM = 256
ALPHA = (2 * DEPTH) ** 0.25
BETA = (8 * DEPTH) ** -0.25
LN_EPS = 1e-5
RMS_EPS = 1e-6

kernel_name = "hybrid_parallel_groups_conv_hgrn2_diffattn_sgu"


def _layer_norm(x, g, b):
    xf = x.astype(jnp.float32)
    mu = jnp.mean(xf, axis=-1, keepdims=True)
    var = jnp.mean(jnp.square(xf - mu), axis=-1, keepdims=True)
    y = (xf - mu) * lax.rsqrt(var + LN_EPS) * g.astype(jnp.float32) + b.astype(jnp.float32)
    return y.astype(x.dtype)


def _rms_norm(x, g):
    xf = x.astype(jnp.float32)
    y = xf * lax.rsqrt(jnp.mean(jnp.square(xf), axis=-1, keepdims=True) + RMS_EPS) * g.astype(jnp.float32)
    return y.astype(x.dtype)


def short_conv_mixer(b, c, xv, w):
    s = xv.shape[1]
    z = c * xv
    zp = jnp.pad(z, ((0, 0), (CONV_W - 1, 0), (0, 0)))
    y = sum(w[j] * zp[:, j:j + s] for j in range(CONV_W))
    return b * y


def hgrn2_mixer(q, fz, iv, lb, norm_g):
    bsz, s, _ = q.shape
    n = s // HG_CHUNK
    fz32 = fz.astype(jnp.float32)
    lb = lb.astype(jnp.float32)
    f = lb + (1.0 - lb) * jax.nn.sigmoid(fz32)
    log_f = jnp.log(jnp.maximum(f, F_FLOOR))
    k = (1.0 - lb) * jax.nn.sigmoid(-fz32)

    def chunks(t):
        return t.astype(jnp.float32).reshape(bsz, n, HG_CHUNK, HG_HEADS, HG_DK).transpose(1, 0, 3, 2, 4)

    qc, kc, vc, gc = chunks(q), chunks(k), chunks(iv), chunks(log_f)
    bc = jnp.cumsum(gc, axis=3)
    causal = jnp.tril(jnp.ones((HG_CHUNK, HG_CHUNK), dtype=bool))[:, :, None]

    def step(state, inp):
        qt, kt, vt, bt = inp
        diff = bt[:, :, :, None, :] - bt[:, :, None, :, :]
        decay = jnp.where(causal, jnp.exp(jnp.where(causal, diff, 0.0)), 0.0)
        a = jnp.einsum('bhtk,bhsk,bhtsk->bhts', qt, kt, decay)
        o = jnp.einsum('bhts,bhsv->bhtv', a, vt) + jnp.einsum('bhtk,bhkv->bhtv', qt * jnp.exp(bt), state)
        b_last = bt[:, :, -1, :]
        new_state = jnp.exp(b_last)[..., None] * state + jnp.einsum(
            'bhsk,bhsv->bhkv', kt * jnp.exp(b_last[:, :, None, :] - bt), vt)
        return new_state, o

    state0 = jnp.zeros((bsz, HG_HEADS, HG_DK, HG_DK), jnp.float32)
    _, o = lax.scan(step, state0, (qc, kc, vc, bc))
    o = o.transpose(1, 0, 3, 2, 4).reshape(bsz, s, HG_HEADS, HG_DK)
    o = _rms_norm(o, norm_g.reshape(HG_HEADS, HG_DK))
    return o.reshape(bsz, s, GROUP_W).astype(q.dtype)


def diff_attn_mixer(q, k, v, lam, lam_init, norm_g):
    bsz, s, _ = q.shape
    nb = s // Q_BLOCK
    q = q.reshape(bsz, s, DA_HEADS, 2, DA_DQK)
    k = k.reshape(bsz, s, DA_HEADS, 2, DA_DQK)
    q1, q2 = q[..., 0, :].transpose(0, 2, 1, 3), q[..., 1, :].transpose(0, 2, 1, 3)
    k1, k2 = k[..., 0, :].transpose(0, 2, 1, 3), k[..., 1, :].transpose(0, 2, 1, 3)
    vh = v.reshape(bsz, s, DA_HEADS, DA_DV).transpose(0, 2, 1, 3)

    def to_blocks(t):
        return t.reshape(bsz, DA_HEADS, nb, Q_BLOCK, DA_DQK).transpose(2, 0, 1, 3, 4)

    qpos = jnp.arange(s).reshape(nb, Q_BLOCK)
    kpos = jnp.arange(s)
    scale = DA_DQK ** -0.5

    def one_block(args):
        q1b, q2b, pos = args
        mask = kpos[None, :] <= pos[:, None]

        def probs(qb, kk):
            sc = jnp.einsum('bhqd,bhkd->bhqk', qb, kk).astype(jnp.float32) * scale
            return jax.nn.softmax(jnp.where(mask, sc, MASK_VALUE), axis=-1)

        a = probs(q1b, k1) - lam * probs(q2b, k2)
        return jnp.einsum('bhqk,bhkv->bhqv', a.astype(vh.dtype), vh)

    o = lax.map(one_block, (to_blocks(q1), to_blocks(q2), qpos))
    o = o.transpose(1, 0, 3, 2, 4).reshape(bsz, s, DA_HEADS, DA_DV)
    o = _rms_norm(o, norm_g.reshape(DA_HEADS, DA_DV)) * (1.0 - lam_init)
    return o.reshape(bsz, s, GROUP_W).astype(q.dtype)


def spatial_gate_mixer(u, v, ln_g, ln_b, ws, bs):
    bsz, s, _ = u.shape
    n = s // SG_CHUNK
    vn = _layer_norm(v, ln_g, ln_b).reshape(bsz, n, SG_CHUNK, SG_GROUPS, SG_CH)
    w = ws * jnp.tril(jnp.ones((SG_CHUNK, SG_CHUNK), ws.dtype))
    sv = jnp.einsum('gts,bnsgc->bntgc', w, vn) + bs.T[:, :, None]
    return u * sv.reshape(bsz, s, GROUP_W)


def setup_inputs(seed: int = 0) -> dict:
    key = jax.random.key(seed)
    ks = jax.random.split(key, 20)
    f32 = jnp.float32
    x = jax.random.normal(ks[0], (BATCH, SEQ, D_MODEL), f32)
    p = jax.random.normal(ks[1], (DEPTH, BATCH, SEQ, PLE_DIM), f32)
    value_blocks = np.array([1, 1, BETA, 1, 1, BETA, 1, 1, BETA, BETA, 1, 1, 1, 1, 1], np.float32)
    col_scale = jnp.asarray(np.repeat(value_blocks, GROUP_W))
    w_in = jax.random.normal(ks[2], (DEPTH, D_MODEL, N_IN_BLOCKS * GROUP_W), f32) * (D_MODEL ** -0.5) * col_scale
    conv_w = jax.random.normal(ks[3], (DEPTH, CONV_W, GROUP_W), f32) * (CONV_W ** -0.5)
    hgrn_lb = jax.random.normal(ks[4], (DEPTH, GROUP_W), f32) * 0.5
    hgrn_norm_g = 1.0 + 0.02 * jax.random.normal(ks[5], (DEPTH, GROUP_W), f32)
    diff_lambda = 0.1 * jax.random.normal(ks[6], (DEPTH, 4, DA_DQK), f32)
    diff_norm_g = 1.0 + 0.02 * jax.random.normal(ks[7], (DEPTH, GROUP_W), f32)
    sg_ln_g = 1.0 + 0.02 * jax.random.normal(ks[8], (DEPTH, GROUP_W), f32)
    sg_ln_b = 0.02 * jax.random.normal(ks[9], (DEPTH, GROUP_W), f32)
    sg_w = jax.random.normal(ks[10], (DEPTH, SG_GROUPS, SG_CHUNK, SG_CHUNK), f32) * (SG_CHUNK ** -0.5)
    sg_b = 1.0 + 0.02 * jax.random.normal(ks[11], (DEPTH, SG_GROUPS, SG_CHUNK), f32)
    w_out = jax.random.normal(ks[12], (DEPTH, D_MIX, D_MODEL), f32) * (D_MIX ** -0.5) * BETA
    ln_g = 1.0 + 0.02 * jax.random.normal(ks[13], (DEPTH, D_MODEL), f32)
    ln_b = 0.02 * jax.random.normal(ks[14], (DEPTH, D_MODEL), f32)
    w_pe = jax.random.normal(ks[15], (DEPTH, PLE_DIM, D_MODEL), f32) * (PLE_DIM ** -0.5)
    w_pg = jax.random.normal(ks[16], (DEPTH, D_MODEL, D_MODEL), f32) * (D_MODEL ** -0.5)
    return {"x": x, "p": p, "w_in": w_in, "conv_w": conv_w, "hgrn_lb": hgrn_lb,
            "hgrn_norm_g": hgrn_norm_g, "diff_lambda": diff_lambda, "diff_norm_g": diff_norm_g,
            "sg_ln_g": sg_ln_g, "sg_ln_b": sg_ln_b, "sg_w": sg_w, "sg_b": sg_b,
            "w_out": w_out, "ln_g": ln_g, "ln_b": ln_b, "w_pe": w_pe, "w_pg": w_pg}


def reference(x, p, w_in, conv_w, hgrn_lb, hgrn_norm_g, diff_lambda, diff_norm_g,
              sg_ln_g, sg_ln_b, sg_w, sg_b, w_out, ln_g, ln_b, w_pe, w_pg):
    lb_sm = jax.nn.softmax(hgrn_lb.astype(jnp.float32), axis=0)
    lower_bounds = jnp.cumsum(lb_sm, axis=0) - lb_sm[0]
    for i in range(DEPTH):
        lam_init = 0.8 - 0.6 * math.exp(-0.3 * i)
        lq1, lk1, lq2, lk2 = (diff_lambda[i, j].astype(jnp.float32) for j in range(4))
        lam = jnp.exp(jnp.sum(lq1 * lk1)) - jnp.exp(jnp.sum(lq2 * lk2)) + lam_init

        h = x @ w_in[i]
        (a_b, a_c, a_x, b_q, b_f, b_i, c_q, c_k, c_v,
         d_u, d_v, g_a, g_b, g_c, g_d) = jnp.split(h, N_IN_BLOCKS, axis=-1)

        y_a = short_conv_mixer(a_b, a_c, a_x, conv_w[i])
        y_b = hgrn2_mixer(b_q, b_f, b_i, lower_bounds[i], hgrn_norm_g[i])
        y_c = diff_attn_mixer(c_q, c_k, c_v, lam, lam_init, diff_norm_g[i])
        y_d = spatial_gate_mixer(jax.nn.gelu(d_u), jax.nn.gelu(d_v), sg_ln_g[i], sg_ln_b[i], sg_w[i], sg_b[i])

        y = jnp.concatenate([y_a * jax.nn.silu(g_a), y_b * jax.nn.silu(g_b),
                             y_c * jax.nn.silu(g_c), y_d * jax.nn.silu(g_d)], axis=-1) @ w_out[i]
        x = _layer_norm(ALPHA * x + y, ln_g[i], ln_b[i])
        x = x + (p[i] @ w_pe[i]) * jax.nn.sigmoid(x @ w_pg[i])
    return x
```

```cpp
#include <hip/hip_runtime.h>
#include <cstdio>
#include <cstdint>
#include <hip/hip_cooperative_groups.h>
namespace cg = cooperative_groups;

namespace pg8 {
#define PG8_LAS __attribute__((address_space(3)))
typedef unsigned short bf16_t;
typedef short bf16x8 __attribute__((ext_vector_type(8)));
typedef float f32x4 __attribute__((ext_vector_type(4)));
typedef unsigned u32x4 __attribute__((ext_vector_type(4)));
constexpr int BM = 256, BK = 64, HALF = 128, HTB = HALF * BK * 2  , STAGE_BYTES = 8 * HTB, NXCD = 8, WGM = 8;

__host__ __device__ __forceinline__ int lds_byte(int r, int c) { const int st = (r >> 4) * 2 + (c >> 5), rr = r & 15, cc = c & 31, ob = rr * 64 + cc * 2; return st * 1024 + (ob ^ (((ob >> 9) & 1) << 5)); }
__host__ __device__ __forceinline__ void stage_rc(int b, int& R, int& C) { const int st = b / 1024, sb = b % 1024, swz = sb ^ (((sb >> 9) & 1) << 5); R = (st >> 1) * 16 + swz / 64; C = (st & 1) * 32 + (swz % 64) / 2; }
__host__ __device__ __forceinline__ int perm32(int rho) { const int n = rho >> 4, i = rho & 15; return 8 * (i >> 2) + 4 * n + (i & 3); }

struct Unit { int pm, pn; };
struct Gemm { const bf16_t* A; const bf16_t* Bt; int M, N, K; };

struct StaticOrder {
    int nM, nN, nwg, G, c;
    __host__ __device__ void init(int M, int N, int G_, int c_) { nM = M / BM; nN = N / BM; nwg = nM * nN; G = G_; c = c_; }
    __host__ __device__ bool next(int i, Unit& u) const {
        const long L = (long)i * G + c; if (L >= nwg) return false;
        int wgid = (int)L; { const int q = nwg / NXCD, r = nwg % NXCD, xcd = wgid % NXCD, off = wgid / NXCD; wgid = (xcd < r ? xcd * (q + 1) : r * (q + 1) + (xcd - r) * q) + off; }
        const int nig = WGM * nN, gid = wgid / nig, fm = gid * WGM, gsz = (nM - fm) < WGM ? (nM - fm) : WGM;
        u.pm = fm + ((wgid % nig) % gsz); u.pn = (wgid % nig) / gsz; return true;
    }
    __device__ __forceinline__ void a_ready(const Unit&) const {}
    __device__ __forceinline__ void done(const Unit&) const {}
};

struct SkipOrder {
    StaticOrder S; int skip0, nskip;
    __host__ __device__ void init(int M, int N, int G_, int c_, int skip0_, int nskip_) { S.init(M, N - nskip_ * BM, G_, c_); skip0 = skip0_; nskip = nskip_; }
    __host__ __device__ bool next(int i, Unit& u) const { if (!S.next(i, u)) return false; if (u.pn >= skip0) u.pn += nskip; return true; }
    __device__ __forceinline__ void a_ready(const Unit&) const {}
    __device__ __forceinline__ void done(const Unit&) const {}
};
__device__ __forceinline__ unsigned cvt_pk_bf16(float lo, float hi) { unsigned r; asm volatile("v_cvt_pk_bf16_f32 %0, %1, %2" : "=v"(r) : "v"(lo), "v"(hi)); return r; }
typedef unsigned u32x2 __attribute__((ext_vector_type(2)));
__device__ __forceinline__ float bf_lo(unsigned w) { return __uint_as_float(w << 16); }
__device__ __forceinline__ float bf_hi(unsigned w) { return __uint_as_float(w & 0xffff0000u); }
__device__ __forceinline__ float act_fn(float v, int act) {
    const float t = (act == 1) ? 1.5957691216057308f * (v + 0.044715f * v * v * v) : v;
    return v * __builtin_amdgcn_rcpf(1.f + __expf(-t));
}
struct EpiH {
    static constexpr bool PERM = true, AFTER_DRAIN = false;
    bf16_t* O; int ldc; int byblock;
    __device__ __forceinline__ void operator()(const f32x4 (&acc)[2][2][4][2], const Unit& u, int wr, int wc, int fr, int fq) const {
        int act = 0; if (byblock) { const int blk = u.pn >> 1; act = (blk == 9 || blk == 10) ? 1 : (blk >= 11 ? 2 : 0); }
        const int row0 = u.pm * BM + wr * 64 + fr, col0 = u.pn * BM + wc * 32 + 8 * fq;
#pragma unroll
        for (int ai = 0; ai < 2; ++ai)
#pragma unroll
            for (int m = 0; m < 4; ++m) { bf16_t* rowp = O + (size_t)(row0 + ai * HALF + m * 16) * ldc + col0;
#pragma unroll
                for (int bj = 0; bj < 2; ++bj) { f32x4 v0 = acc[ai][bj][m][0], v1 = acc[ai][bj][m][1];
                    if (act != 0) {
#pragma unroll
                        for (int e = 0; e < 4; ++e) { v0[e] = act_fn(v0[e], act); v1[e] = act_fn(v1[e], act); } }
                    u32x4 w; w.x = cvt_pk_bf16(v0[0], v0[1]); w.y = cvt_pk_bf16(v0[2], v0[3]); w.z = cvt_pk_bf16(v1[0], v1[1]); w.w = cvt_pk_bf16(v1[2], v1[3]);
                    *(u32x4*)(rowp + bj * HALF) = w; } }
    }
};
__device__ __forceinline__ float sum_fq(float v) {
    auto a = __builtin_amdgcn_permlane16_swap(__float_as_uint(v), __float_as_uint(v), false, false); v = __uint_as_float(a[0]) + __uint_as_float(a[1]);
    auto b = __builtin_amdgcn_permlane32_swap(__float_as_uint(v), __float_as_uint(v), false, false); return __uint_as_float(b[0]) + __uint_as_float(b[1]); }
struct EpiZ {
    static constexpr bool PERM = true, AFTER_DRAIN = false;
    const float* X; float* Z; bf16_t* ZB; float* ST; int ldc; float alpha;
    __device__ __forceinline__ void operator()(const f32x4 (&acc)[2][2][4][2], const Unit& u, int wr, int wc, int fr, int fq) const {
        const int row0 = u.pm * BM + wr * 64 + fr, col0 = u.pn * BM + wc * 32 + 8 * fq;
#pragma unroll
        for (int ai = 0; ai < 2; ++ai)
#pragma unroll
            for (int m = 0; m < 4; ++m) { const int row = row0 + ai * HALF + m * 16; const size_t off = (size_t)row * ldc + col0; float s1 = 0.f, s2 = 0.f;
#pragma unroll
                for (int bj = 0; bj < 2; ++bj) { const size_t o2 = off + bj * HALF; const f32x4 x0 = *(const f32x4*)(X + o2), x1 = *(const f32x4*)(X + o2 + 4);
                    const f32x4 z0 = x0 * alpha + acc[ai][bj][m][0], z1 = x1 * alpha + acc[ai][bj][m][1];
                    u32x4 w; w.x = cvt_pk_bf16(z0[0], z0[1]); w.y = cvt_pk_bf16(z0[2], z0[3]); w.z = cvt_pk_bf16(z1[0], z1[1]); w.w = cvt_pk_bf16(z1[2], z1[3]); *(u32x4*)(ZB + o2) = w;
                    s1 += ((z0[0] + z0[1]) + (z0[2] + z0[3])) + ((z1[0] + z1[1]) + (z1[2] + z1[3]));
                    s2 += ((z0[0] * z0[0] + z0[1] * z0[1]) + (z0[2] * z0[2] + z0[3] * z0[3])) + ((z1[0] * z1[0] + z1[1] * z1[1]) + (z1[2] * z1[2] + z1[3] * z1[3])); }
                s1 = sum_fq(s1); s2 = sum_fq(s2);
                if (fq == 0) { atomicAdd(ST + 2 * row, s1); atomicAdd(ST + 2 * row + 1, s2); } }
    }
};
struct EpiPG {
    static constexpr bool PERM = true, AFTER_DRAIN = false;
    const bf16_t* Zb; const float* ST; const float* C1; const float* C2; const float* LG; const float* LB; const bf16_t* PE; float* OUTF; bf16_t* XB; int ldc;
    __device__ __forceinline__ void operator()(const f32x4 (&acc)[2][2][4][2], const Unit& u, int wr, int wc, int fr, int fq) const {
        const int row0 = u.pm * BM + wr * 64 + fr, col0 = u.pn * BM + wc * 32 + 8 * fq;
#pragma unroll
        for (int bj = 0; bj < 2; ++bj) { const int col = col0 + bj * HALF;
            f32x4 c1[2], c2[2], lg[2], lb[2];
#pragma unroll
            for (int n = 0; n < 2; ++n) { c1[n] = *(const f32x4*)(C1 + col + 4 * n); c2[n] = *(const f32x4*)(C2 + col + 4 * n); lg[n] = *(const f32x4*)(LG + col + 4 * n); lb[n] = *(const f32x4*)(LB + col + 4 * n); }
#pragma unroll
            for (int ai = 0; ai < 2; ++ai)
#pragma unroll
                for (int m = 0; m < 4; ++m) { const int row = row0 + ai * HALF + m * 16; const size_t o2 = (size_t)row * ldc + col;
                    const float s1 = ST[2 * row], s2 = ST[2 * row + 1], mu = s1 * (1.f / 2048.f), rstd = __builtin_amdgcn_rsqf(fmaxf(s2 * (1.f / 2048.f) - mu * mu, 0.f) + 1e-5f);
                    const u32x4 zw = *(const u32x4*)(Zb + o2), pw = *(const u32x4*)(PE + o2); u32x4 xw;
#pragma unroll
                    for (int n = 0; n < 2; ++n) { const unsigned za = n ? zw.z : zw.x, zb2 = n ? zw.w : zw.y, pa = n ? pw.z : pw.x, pb = n ? pw.w : pw.y;
                        const f32x4 zv = (f32x4){bf_lo(za), bf_hi(za), bf_lo(zb2), bf_hi(zb2)}, pv = (f32x4){bf_lo(pa), bf_hi(pa), bf_lo(pb), bf_hi(pb)}; const f32x4 a = acc[ai][bj][m][n]; f32x4 o;
                        const float mur = mu * rstd; const f32x4 t = (a * rstd + (c2[n] - c1[n] * mur)) * (-1.4426950408889634f), xl = (zv * rstd - mur) * lg[n] + lb[n]; f32x4 r;
                        r[0] = __builtin_amdgcn_rcpf(1.f + __builtin_amdgcn_exp2f(t[0])); r[1] = __builtin_amdgcn_rcpf(1.f + __builtin_amdgcn_exp2f(t[1])); r[2] = __builtin_amdgcn_rcpf(1.f + __builtin_amdgcn_exp2f(t[2])); r[3] = __builtin_amdgcn_rcpf(1.f + __builtin_amdgcn_exp2f(t[3]));
                        o = xl + pv * r;
                        *(f32x4*)(OUTF + o2 + 4 * n) = o; if (n == 0) { xw.x = cvt_pk_bf16(o[0], o[1]); xw.y = cvt_pk_bf16(o[2], o[3]); } else { xw.z = cvt_pk_bf16(o[0], o[1]); xw.w = cvt_pk_bf16(o[2], o[3]); } }
                    if (XB) *(u32x4*)(XB + o2) = xw; }
            asm volatile("" ::: "memory"); }
    }
};
template <class Epi, class Sched, bool ALIGN_EPI = false, bool SP2 = false>
__device__ __forceinline__ void gemm_phase(PG8_LAS unsigned char* lds, const Gemm g, const Sched& S, const Epi& E) {
    int tid_ = threadIdx.x; asm volatile("" : "+v"(tid_)); const int tid = tid_, wid = __builtin_amdgcn_readfirstlane(tid >> 6), lane = tid & 63, wr = wid >> 2, wc = wid & 3, fr = lane & 15, fq = lane >> 4;
    const int K = g.K, nt = K / BK;
    unsigned voffA[2], voffB[2];
#pragma unroll
    for (int i = 0; i < 2; ++i) { int R, C; stage_rc(tid * 16 + i * 8192, R, C); const int Rb = Epi::PERM ? ((R & ~31) + perm32(R & 31)) : R;
        voffA[i] = (unsigned)(R * K + C) * 2u; voffB[i] = (unsigned)(Rb * K + C) * 2u; }
    const size_t kstep = (size_t)(BK * 2);
    const size_t hstep = (size_t)HALF * K * 2;
    const size_t tstep = 2 * hstep;
    const unsigned ldsw = (unsigned)wid * 1024u;
    const int aoff = lds_byte(wr * 64 + fr, fq * 8), boff = lds_byte(wc * 32 + fr, fq * 8);
#define PG8_SA(b, h) (((b) * 2 + (h)) * HTB)
#define PG8_SB(b, h) ((4 + (b) * 2 + (h)) * HTB)
#define PG8_STAGE(bufoff, gbase, voff) do { _Pragma("unroll") for (int _i = 0; _i < 2; ++_i) \
        __builtin_amdgcn_global_load_lds((const unsigned*)((const char*)(gbase) + (voff)[_i]), (PG8_LAS unsigned*)(lds + (bufoff) + ldsw + _i * 8192), 16, 0, 0); } while (0)
#define PG8_LDA(dst, b, h) do { _Pragma("unroll") for (int m = 0; m < 4; ++m) _Pragma("unroll") for (int k = 0; k < 2; ++k) dst[m][k] = *(const PG8_LAS bf16x8*)(lds + PG8_SA(b, h) + aoff + m * 2048 + k * 1024); } while (0)
#define PG8_LDB(dst, b, h) do { _Pragma("unroll") for (int n = 0; n < 2; ++n) _Pragma("unroll") for (int k = 0; k < 2; ++k) dst[n][k] = *(const PG8_LAS bf16x8*)(lds + PG8_SB(b, h) + boff + n * 2048 + k * 1024); } while (0)
#define PG8_MMA(ai, bj, At, Bt) do { __builtin_amdgcn_s_setprio(1); _Pragma("unroll") for (int m = 0; m < 4; ++m) _Pragma("unroll") for (int n = 0; n < 2; ++n) _Pragma("unroll") for (int k = 0; k < 2; ++k) \
        acc[ai][bj][m][n] = __builtin_amdgcn_mfma_f32_16x16x32_bf16(Bt[n][k], At[m][k], acc[ai][bj][m][n], 0, 0, 0); __builtin_amdgcn_s_setprio(0); } while (0)
#define PG8_WAIT_V(n) asm volatile("s_waitcnt vmcnt(" #n ")" ::: "memory")
#define PG8_WAIT_L(n) asm volatile("s_waitcnt lgkmcnt(" #n ")" ::: "memory")
#define PG8_BAR __builtin_amdgcn_s_barrier()
#define PG8_SCHED __builtin_amdgcn_sched_barrier(0)
    Unit cur, nxt; int ui = 0;
    if (!S.next(0, cur)) return;
    f32x4 acc[2][2][4][2];
#pragma unroll
    for (int a = 0; a < 2; ++a)
#pragma unroll
        for (int b = 0; b < 2; ++b)
#pragma unroll
            for (int m = 0; m < 4; ++m)
#pragma unroll
                for (int n = 0; n < 2; ++n) acc[a][b][m][n] = (f32x4){0.f, 0.f, 0.f, 0.f};
    bf16x8 At[4][2], B0[2][2], B1[2][2];
    const char* cA = (const char*)g.A + (size_t)cur.pm * tstep; const char* cB = (const char*)g.Bt + (size_t)cur.pn * tstep;
    S.a_ready(cur);
    if constexpr (SP2) {
        PG8_STAGE(PG8_SB(0, 0), cB, voffB); PG8_STAGE(PG8_SB(0, 1), cB + hstep, voffB); PG8_STAGE(PG8_SA(0, 0), cA, voffA); PG8_STAGE(PG8_SA(0, 1), cA + hstep, voffA);
        if (wr == 1) PG8_BAR;
        PG8_WAIT_V(2); PG8_BAR;
        PG8_STAGE(PG8_SB(1, 0), cB + kstep, voffB); PG8_STAGE(PG8_SA(1, 0), cA + kstep, voffA); PG8_STAGE(PG8_SB(1, 1), cB + hstep + kstep, voffB);
        PG8_WAIT_V(6); PG8_BAR;
    } else {
        PG8_STAGE(PG8_SB(0, 0), cB, voffB); PG8_STAGE(PG8_SA(0, 0), cA, voffA); PG8_STAGE(PG8_SB(0, 1), cB + hstep, voffB); PG8_STAGE(PG8_SA(0, 1), cA + hstep, voffA);
        if (wr == 1) PG8_BAR;
        PG8_WAIT_V(4); PG8_BAR;
        PG8_STAGE(PG8_SB(1, 0), cB + kstep, voffB); PG8_STAGE(PG8_SA(1, 0), cA + kstep, voffA); PG8_STAGE(PG8_SB(1, 1), cB + hstep + kstep, voffB);
        PG8_WAIT_V(6); PG8_BAR;
    }
    for (;;) {
        const bool has_next = S.next(ui + 1, nxt);
        const char* nA = has_next ? (const char*)g.A + (size_t)nxt.pm * tstep : cA; const char* nB = has_next ? (const char*)g.Bt + (size_t)nxt.pn * tstep : cB;
        for (int t = 0; t < nt; t += 2) {
            const bool last = (t == nt - 2);
            const char* a1 = cA + (size_t)(t + 1) * kstep;
            const char* a2 = last ? nA : cA + (size_t)(t + 2) * kstep; const char* b2 = last ? nB : cB + (size_t)(t + 2) * kstep;
            const char* a3 = a2 + kstep; const char* b3 = b2 + kstep;
            if (last && has_next) S.a_ready(nxt);
            if constexpr (SP2) {
            PG8_LDB(B0, 0, 0); PG8_LDB(B1, 0, 1); PG8_SCHED; PG8_LDA(At, 0, 0); PG8_STAGE(PG8_SA(1, 1), a1 + hstep, voffA);
            PG8_WAIT_V(8); PG8_WAIT_L(0); PG8_BAR; PG8_MMA(0, 0, At, B0); PG8_MMA(0, 1, At, B1); PG8_BAR; PG8_SCHED;
            PG8_LDA(At, 0, 1); PG8_STAGE(PG8_SB(0, 0), b2, voffB); PG8_STAGE(PG8_SB(0, 1), b2 + hstep, voffB); PG8_STAGE(PG8_SA(0, 0), a2, voffA);
            PG8_WAIT_V(8); PG8_WAIT_L(0); PG8_BAR; PG8_MMA(1, 0, At, B0); PG8_MMA(1, 1, At, B1); PG8_BAR; PG8_SCHED;
            PG8_LDB(B0, 1, 0); PG8_LDB(B1, 1, 1); PG8_SCHED; PG8_LDA(At, 1, 0); PG8_STAGE(PG8_SA(0, 1), a2 + hstep, voffA);
            PG8_WAIT_V(8); PG8_WAIT_L(0); PG8_BAR; PG8_MMA(0, 0, At, B0); PG8_MMA(0, 1, At, B1); PG8_BAR; PG8_SCHED;
            PG8_LDA(At, 1, 1); PG8_STAGE(PG8_SB(1, 0), b3, voffB); PG8_STAGE(PG8_SB(1, 1), b3 + hstep, voffB); PG8_STAGE(PG8_SA(1, 0), a3, voffA);
            PG8_WAIT_V(8); PG8_WAIT_L(0); PG8_BAR; PG8_MMA(1, 0, At, B0); PG8_MMA(1, 1, At, B1); PG8_BAR; PG8_SCHED;
            } else {
            PG8_LDB(B0, 0, 0); PG8_SCHED; PG8_LDA(At, 0, 0); PG8_STAGE(PG8_SA(1, 1), a1 + hstep, voffA);
            PG8_WAIT_L(8); PG8_BAR; PG8_WAIT_L(0); PG8_MMA(0, 0, At, B0); PG8_BAR; PG8_SCHED;
            PG8_LDB(B1, 0, 1); PG8_STAGE(PG8_SB(0, 0), b2, voffB);
            PG8_BAR; PG8_WAIT_L(0); PG8_MMA(0, 1, At, B1); PG8_BAR;
            PG8_LDA(At, 0, 1); PG8_STAGE(PG8_SA(0, 0), a2, voffA);
            PG8_BAR; PG8_WAIT_L(0); PG8_MMA(1, 0, At, B0); PG8_BAR; PG8_SCHED;
            PG8_STAGE(PG8_SB(0, 1), b2 + hstep, voffB);
            PG8_WAIT_V(6); PG8_BAR; PG8_MMA(1, 1, At, B1); PG8_BAR;
            PG8_LDB(B0, 1, 0); PG8_SCHED; PG8_LDA(At, 1, 0); PG8_STAGE(PG8_SA(0, 1), a2 + hstep, voffA);
            PG8_WAIT_L(8); PG8_BAR; PG8_WAIT_L(0); PG8_MMA(0, 0, At, B0); PG8_BAR; PG8_SCHED;
            PG8_LDB(B1, 1, 1); PG8_STAGE(PG8_SB(1, 0), b3, voffB);
            PG8_BAR; PG8_WAIT_L(0); PG8_MMA(0, 1, At, B1); PG8_BAR;
            PG8_LDA(At, 1, 1); PG8_STAGE(PG8_SA(1, 0), a3, voffA);
            PG8_BAR; PG8_WAIT_L(0); PG8_MMA(1, 0, At, B0); PG8_BAR; PG8_SCHED;
            PG8_STAGE(PG8_SB(1, 1), b3 + hstep, voffB);
            PG8_WAIT_V(6); PG8_BAR; PG8_MMA(1, 1, At, B1); PG8_BAR;
            }
        }
        if constexpr (ALIGN_EPI) { if (wr == 0) PG8_BAR; }
        if constexpr (!Epi::AFTER_DRAIN) { E(acc, cur, wr, wc, fr, fq); S.done(cur); }
        if (!has_next) break;
#pragma unroll
        for (int a = 0; a < 2; ++a)
#pragma unroll
            for (int b = 0; b < 2; ++b)
#pragma unroll
                for (int m = 0; m < 4; ++m)
#pragma unroll
                    for (int n = 0; n < 2; ++n) acc[a][b][m][n] = (f32x4){0.f, 0.f, 0.f, 0.f};
        cur = nxt; cA = nA; cB = nB; ++ui;
        if constexpr (ALIGN_EPI) { if (wr == 1) PG8_BAR; }
    }
    PG8_WAIT_V(0);
    if constexpr (!ALIGN_EPI) { if (wr == 0) PG8_BAR; }
    PG8_BAR;
    if constexpr (Epi::AFTER_DRAIN) { E.fused(acc, cur, wr, wc, fr, fq, lds, wid, lane); S.done(cur); }
#undef PG8_SA
#undef PG8_SB
#undef PG8_STAGE
#undef PG8_LDA
#undef PG8_LDB
#undef PG8_MMA
#undef PG8_WAIT_V
#undef PG8_WAIT_L
#undef PG8_BAR
#undef PG8_SCHED
}
}
#ifndef DIS
#define DIS 0
#endif
#ifndef NAIVE_ATTN
#define NAIVE_ATTN 0
#endif
#ifndef MK_PER_PHASE
#define MK_PER_PHASE 0
#endif
constexpr int NB = 2, SEQ = 4096, MT = NB * SEQ, DM = 2048, NH = 7680, GW = 512, PLE = 256, DEPTH = 2;
constexpr int C_AB = 0, C_AC = 512, C_AX = 1024, C_BQ = 1536, C_BF = 2048, C_BI = 2560, C_CQ = 3072, C_CK = 3584, C_CV = 4096, C_DU = 4608, C_DV = 5120, C_GA = 5632, C_GB = 6144, C_GC = 6656, C_GD = 7168;
constexpr int Y_A = 0, Y_B = 512, Y_C = 1024, Y_D = 1536;
constexpr float ALPHA = 1.4142135623730951f;
constexpr float LN_EPS = 1e-5f, RMS_EPS = 1e-6f;
constexpr size_t MiB = 1u << 20;
constexpr size_t WS_WIN = 2 * MiB, WS_WOUT = 62 * MiB, WS_WPG = 78 * MiB, WS_WPE = 94 * MiB, WS_XB = 96 * MiB, WS_PB = 128 * MiB, WS_PE = 136 * MiB, WS_H = 168 * MiB,
                 WS_VT = 288 * MiB, WS_YCAT = 296 * MiB, WS_Z = 328 * MiB, WS_ATMP = 328 * MiB  , WS_XLNB = 392 * MiB, WS_HS = 424 * MiB  , WS_SB = 456 * MiB  , WS_DD = 472 * MiB  , WS_END = 473 * MiB;
constexpr int LDS_BYTES = 147456;
typedef unsigned short bf16;
typedef unsigned v4u __attribute__((ext_vector_type(4)));
typedef unsigned v2u __attribute__((ext_vector_type(2)));
typedef float f32x4 __attribute__((ext_vector_type(4)));
#define LAS __attribute__((address_space(3)))
#define GAS __attribute__((address_space(1)))
#define LDS_WAIT() asm volatile("s_waitcnt lgkmcnt(0)" ::: "memory")
__device__ __forceinline__ unsigned pk2(float lo, float hi) { unsigned r; asm("v_cvt_pk_bf16_f32 %0, %1, %2" : "=v"(r) : "v"(lo), "v"(hi)); return r; }
__device__ __forceinline__ unsigned f2bf(float f) { return pk2(f, 0.f) & 0xffffu; }
__device__ __forceinline__ float bfe(const v4u& v, int e) { const unsigned w = v[e >> 1]; return (e & 1) ? __uint_as_float(w & 0xffff0000u) : __uint_as_float(w << 16); }
__device__ __forceinline__ float bf1(bf16 b) { return __uint_as_float(((unsigned)b) << 16); }
__device__ __forceinline__ float wave_sum(float v) {
#pragma unroll
    for (int o = 1; o < 64; o <<= 1) v += __shfl_xor(v, o);
    return v;
}
__device__ __forceinline__ void p0_transpose_item(const float* W, int K, int N, bf16* WT, float* scr, int item, int lane, const float* scale, const float* cb, float* c1, float* c2) {
    const int nblk = N / 64, kb = item / nblk, nb = item % nblk, k0 = 64 * kb, n0 = 64 * nb;
    const int lr = lane >> 4, lc = (lane & 15) * 4;
    f32x4 v[16];
#pragma unroll
    for (int i = 0; i < 16; ++i) v[i] = *(const f32x4*)(W + (size_t)(k0 + 4 * i + lr) * N + n0 + lc);
#pragma unroll
    for (int i = 0; i < 16; ++i) { const int kk = 4 * i + lr; f32x4 w = v[i]; if (scale) w = w * scale[k0 + kk]; float* d = scr + kk * 65 + lc; d[0] = w[0]; d[1] = w[1]; d[2] = w[2]; d[3] = w[3]; }
    LDS_WAIT(); asm volatile("" ::: "memory");
    const int c = lane & 7;
#pragma unroll
    for (int j = 0; j < 8; ++j) { const int n = (lane >> 3) + 8 * j; const float* sp = scr + (8 * c) * 65 + n;
        v4u o; o.x = pk2(sp[0 * 65], sp[1 * 65]); o.y = pk2(sp[2 * 65], sp[3 * 65]); o.z = pk2(sp[4 * 65], sp[5 * 65]); o.w = pk2(sp[6 * 65], sp[7 * 65]);
        *(v4u*)(WT + (size_t)(n0 + n) * K + k0 + 8 * c) = o; }
    if (c1) { float a1 = 0.f, a2 = 0.f;
        for (int kk = 0; kk < 64; ++kk) { a1 += __uint_as_float(f2bf(scr[kk * 65 + lane]) << 16); a2 += cb[k0 + kk] * W[(size_t)(k0 + kk) * N + n0 + lane]; }
        atomicAdd(c1 + n0 + lane, a1); atomicAdd(c2 + n0 + lane, a2); }
    LDS_WAIT(); asm volatile("" ::: "memory");
}

#define RLX_AGENT __ATOMIC_RELAXED, __HIP_MEMORY_SCOPE_AGENT
#define XB_TMO      128
#define XB_XCNT(j)  (256  + 64 * (j))
#define XB_XSUB(j)  (1280 + 64 * (j))
#define XB_XGEN(j)  (2304 + 64 * (j))
#define XB_TOP      3328
#define XB_TOPGEN   3392
#define XCD_BAR_WORDS 3456
#define XB_SPIN_CAP (1u << 18)

__device__ __forceinline__ unsigned xb_ld(unsigned* p)              { return __hip_atomic_load(p, __ATOMIC_RELAXED, __HIP_MEMORY_SCOPE_AGENT); }
__device__ __forceinline__ unsigned xb_add(unsigned* p, unsigned v) { return __hip_atomic_fetch_add(p, v, __ATOMIC_RELAXED, __HIP_MEMORY_SCOPE_AGENT); }
__device__ __forceinline__ unsigned xb_xcc_id() { return (unsigned)__builtin_amdgcn_s_getreg((3 << 11) | 20) & 0xFu; }
#define XB_SPIN(cond, bar) do { unsigned _sp = 0; while (cond) { __builtin_amdgcn_s_sleep(1); \
    if ((++_sp & 255u) == 0u) { if (xb_ld(&(bar)[XB_TMO])) break; if (_sp > XB_SPIN_CAP) { atomicAdd(&(bar)[XB_TMO], 1u); break; } } } } while (0)

struct XcdBarrier {
    unsigned* bar; unsigned x;
    volatile LAS unsigned* st;
};

__device__ __forceinline__ XcdBarrier xcd_barrier_post(unsigned* bar, volatile LAS unsigned* st) {
    XcdBarrier b; b.bar = bar; b.x = xb_xcc_id(); b.st = st;
    if (threadIdx.x == 0) (void)xb_add(&bar[XB_XCNT(b.x)], 1u);
    return b;
}
__device__ __forceinline__ void xcd_barrier_complete(unsigned* bar, unsigned x, unsigned& nloc, unsigned& nx) {
    const unsigned G = gridDim.x * gridDim.y * gridDim.z;
    unsigned sum, cnt, mine, sp = 0u;
    for (;;) {
        sum = 0u; cnt = 0u; mine = 0u;
#pragma unroll
        for (unsigned j = 0; j < 16; ++j) { const unsigned c = xb_ld(&bar[XB_XCNT(j)]); sum += c; cnt += (c > 0u) ? 1u : 0u; mine = (j == x) ? c : mine; }
        if (sum == G) break;
        __builtin_amdgcn_s_sleep(1);
        if ((++sp & 255u) == 0u) { if (xb_ld(&bar[XB_TMO])) break; if (sp > XB_SPIN_CAP) { atomicAdd(&bar[XB_TMO], 1u); break; } }
    }
    nloc = mine > 0u ? mine : 1u; nx = cnt > 0u ? cnt : 1u;
}

__device__ __forceinline__ void xcd_barrier(const XcdBarrier& b) {
    asm volatile("s_waitcnt vmcnt(0)" ::: "memory");
    __syncthreads();
    if (threadIdx.x == 0) {
        unsigned* bar = b.bar;
        __builtin_amdgcn_s_waitcnt(0);
        unsigned nloc = b.st[0], nx = b.st[1];
        if (nloc == 0u) { xcd_barrier_complete(bar, b.x, nloc, nx); b.st[0] = nloc; b.st[1] = nx; }
        const unsigned old = xb_add(&bar[XB_XSUB(b.x)], 1u);
        const unsigned gen = old / nloc;
        if (old + 1u == (gen + 1u) * nloc) {
            __builtin_amdgcn_fence(__ATOMIC_RELEASE, "agent");
            asm volatile("s_waitcnt vmcnt(0)" ::: "memory");
            const unsigned og = xb_add(&bar[XB_TOP], 1u);
            const unsigned tg = og / nx;
            if (og + 1u == (tg + 1u) * nx) xb_add(&bar[XB_TOPGEN], 1u);
            else XB_SPIN(xb_ld(&bar[XB_TOPGEN]) == tg, bar);
            __builtin_amdgcn_fence(__ATOMIC_ACQUIRE, "agent");
            xb_add(&bar[XB_XGEN(b.x)], 1u);
            asm volatile("s_waitcnt vmcnt(0)" ::: "memory");
        } else {
            XB_SPIN(xb_ld(&bar[XB_XGEN(b.x)]) == gen, bar);
            __builtin_amdgcn_fence(__ATOMIC_ACQUIRE, "agent");
            asm volatile("s_waitcnt vmcnt(0)" ::: "memory");
        }
    }
    __syncthreads();
}

__device__ __forceinline__ void xcd_barrier_arrive(const XcdBarrier& b) {
    asm volatile("s_waitcnt vmcnt(0)" ::: "memory");
    __syncthreads();
    if (threadIdx.x == 0) {
        unsigned* bar = b.bar;
        __builtin_amdgcn_s_waitcnt(0);
        unsigned nloc = b.st[0], nx = b.st[1];
        if (nloc == 0u) { xcd_barrier_complete(bar, b.x, nloc, nx); b.st[0] = nloc; b.st[1] = nx; }
        const unsigned old = xb_add(&bar[XB_XSUB(b.x)], 1u);
        const unsigned gen = old / nloc;
        unsigned role = 0u, tg = 0u;
        if (old + 1u == (gen + 1u) * nloc) {
            __builtin_amdgcn_fence(__ATOMIC_RELEASE, "agent");
            asm volatile("s_waitcnt vmcnt(0)" ::: "memory");
            const unsigned og = xb_add(&bar[XB_TOP], 1u);
            tg = og / nx; role = 1u;
            if (og + 1u == (tg + 1u) * nx) { xb_add(&bar[XB_TOPGEN], 1u); role = 2u; }
        }
        b.st[2] = role; b.st[3] = gen; b.st[4] = tg;
    }
}
__device__ __forceinline__ void xcd_barrier_wait(const XcdBarrier& b) {
    if (threadIdx.x == 0) {
        unsigned* bar = b.bar; const unsigned role = b.st[2], gen = b.st[3], tg = b.st[4];
        if (role) {
            if (role == 1u) XB_SPIN(xb_ld(&bar[XB_TOPGEN]) == tg, bar);
            __builtin_amdgcn_fence(__ATOMIC_ACQUIRE, "agent");
            xb_add(&bar[XB_XGEN(b.x)], 1u);
            asm volatile("s_waitcnt vmcnt(0)" ::: "memory");
        } else {
            XB_SPIN(xb_ld(&bar[XB_XGEN(b.x)]) == gen, bar);
            __builtin_amdgcn_fence(__ATOMIC_ACQUIRE, "agent");
            asm volatile("s_waitcnt vmcnt(0)" ::: "memory");
        }
    }
    __syncthreads();
}
__device__ __forceinline__ int tid_opaque() { int t = threadIdx.x; asm volatile("" : "+v"(t)); return t; }
struct Args { const float* in[17]; float* out; unsigned char* ws; int ph_lo, ph_hi; };

__device__ __forceinline__ void mix_conv(const bf16* h, const float* cw, bf16* ycat, int gtid, int gstride) {
    for (int it = gtid; it < MT * 64; it += gstride) {
        const int m = it >> 6, c = (it & 63) * 8, t = m & (SEQ - 1);
        const bf16* hr = h + (size_t)m * NH;
        const v4u bb = *(const v4u*)(hr + C_AB + c), ga = *(const v4u*)(hr + C_GA + c);
        float acc[8];
#pragma unroll
        for (int e = 0; e < 8; ++e) acc[e] = 0.f;
#pragma unroll
        for (int j = 0; j < 3; ++j) { const int dt = 2 - j;
            if (t - dt >= 0) { const bf16* hp = hr - (size_t)dt * NH; const v4u cc = *(const v4u*)(hp + C_AC + c), xx = *(const v4u*)(hp + C_AX + c);
#pragma unroll
                for (int e = 0; e < 8; ++e) acc[e] += cw[j * GW + c + e] * (bfe(cc, e) * bfe(xx, e)); } }
        v4u o;
#pragma unroll
        for (int e = 0; e < 4; ++e) o[e] = pk2(bfe(bb, 2 * e) * acc[2 * e] * bfe(ga, 2 * e), bfe(bb, 2 * e + 1) * acc[2 * e + 1] * bfe(ga, 2 * e + 1));
        *(v4u*)(ycat + (size_t)m * DM + Y_A + c) = o;
    }
}
__device__ __forceinline__ void mix_sgu(const bf16* h, const float* lng, const float* lnb, const float* sgw, const float* sgb, bf16* ycat, char* lds, int wg, int nwg) {
    typedef _Float16 sbf16x8 __attribute__((ext_vector_type(8)));
    const int tid = tid_opaque(), lane = tid & 63, wid = __builtin_amdgcn_readfirstlane(tid >> 6), li = lane & 15, g = lane >> 4;
    for (int item = wg; item < NB * 32 * 4; item += nwg) {
        const int grp = item & 3, n = (item >> 2) & 31, b = item >> 7;
        const size_t m0 = (size_t)b * SEQ + n * 128;
#pragma unroll
        for (int i = 0; i < 8; ++i) { const int idx = tid + 512 * i, t = idx >> 5, s4 = (idx & 31) * 4; const f32x4 w = *(const f32x4*)(sgw + (size_t)grp * 16384 + t * 128 + s4);
            typedef _Float16 h4 __attribute__((ext_vector_type(4))); h4 o; o[0] = (_Float16)(s4 <= t ? w[0] : 0.f); o[1] = (_Float16)(s4 + 1 <= t ? w[1] : 0.f); o[2] = (_Float16)(s4 + 2 <= t ? w[2] : 0.f); o[3] = (_Float16)(s4 + 3 <= t ? w[3] : 0.f); *(h4*)(lds + t * 288 + s4 * 2) = o; }
        { const int row = tid >> 2, q = tid & 3; const bf16* vr = h + (m0 + row) * NH + C_DV;
          float s1 = 0.f, s2 = 0.f;
#pragma unroll
          for (int j = 0; j < 16; ++j) { const v4u vv = *(const v4u*)(vr + (4 * j + q) * 8);
#pragma unroll
              for (int e = 0; e < 8; ++e) { const float x = bfe(vv, e); s1 += x; s2 += x * x; } }
          s1 += __shfl_xor(s1, 1); s1 += __shfl_xor(s1, 2); s2 += __shfl_xor(s2, 1); s2 += __shfl_xor(s2, 2);
          const float mu = s1 * (1.f / 512.f), rstd = rsqrtf(fmaxf(s2 * (1.f / 512.f) - mu * mu, 0.f) + LN_EPS);
#pragma unroll
          for (int j = 0; j < 4; ++j) { const int c0 = 32 * q + 8 * j; const v4u vv = *(const v4u*)(vr + 128 * grp + c0);
#pragma unroll
              for (int e = 0; e < 8; ++e) { const float y = (bfe(vv, e) - mu) * rstd * lng[128 * grp + c0 + e] + lnb[128 * grp + c0 + e]; *(_Float16*)(lds + 36864 + (c0 + e) * 288 + row * 2) = (_Float16)y; } } }
        __syncthreads();
        pg8::f32x4 acc[8];
#pragma unroll
        for (int nb = 0; nb < 8; ++nb) acc[nb] = (pg8::f32x4){0.f, 0.f, 0.f, 0.f};
        const int nks = (16 * wid + 15) / 32 + 1;
        for (int ks = 0; ks < nks; ++ks) { const sbf16x8 wf = *(const sbf16x8*)(lds + (16 * wid + li) * 288 + ks * 64 + g * 16);
#pragma unroll
            for (int nb = 0; nb < 8; ++nb) { const sbf16x8 vf = *(const sbf16x8*)(lds + 36864 + (16 * nb + li) * 288 + ks * 64 + g * 16); acc[nb] = __builtin_amdgcn_mfma_f32_16x16x32_f16(vf, wf, acc[nb], 0, 0, 0); } }
        { const int t = 16 * wid + li; const float bias = sgb[grp * 128 + t];
          const bf16* hr = h + (m0 + t) * NH + 128 * grp + 4 * g; bf16* yr = ycat + (m0 + t) * DM + Y_D + 128 * grp + 4 * g;
#pragma unroll
          for (int nb = 0; nb < 8; ++nb) { const v2u uu = *(const v2u*)(hr + C_DU + 16 * nb), gd = *(const v2u*)(hr + C_GD + 16 * nb);
              v2u o; o.x = pk2(__uint_as_float(uu.x << 16) * (acc[nb][0] + bias) * __uint_as_float(gd.x << 16), __uint_as_float(uu.x & 0xffff0000u) * (acc[nb][1] + bias) * __uint_as_float(gd.x & 0xffff0000u));
              o.y = pk2(__uint_as_float(uu.y << 16) * (acc[nb][2] + bias) * __uint_as_float(gd.y << 16), __uint_as_float(uu.y & 0xffff0000u) * (acc[nb][3] + bias) * __uint_as_float(gd.y & 0xffff0000u));
              *(v2u*)(yr + 16 * nb) = o; } }
        __syncthreads();
    }
}
typedef short hbf16x8 __attribute__((ext_vector_type(8)));
__device__ __forceinline__ float hg_lb(const float* lbraw, int layer, int ch) { if (layer == 0) return 0.f; const float e0 = __expf(lbraw[ch]), e1 = __expf(lbraw[GW + ch]); return e1 / (e0 + e1); }
__device__ __forceinline__ void hg_gate(float fzraw, float lb, float& gl, float& kk) { const float fz = fminf(fmaxf(fzraw, -80.f), 80.f), ex = __expf(-fz), sg = __builtin_amdgcn_rcpf(1.f + ex);
    gl = __builtin_amdgcn_logf(fmaxf(lb + (1.f - lb) * sg, 1e-30f)) * 0.6931471805599453f;     kk = (1.f - lb) * (ex * sg); }
__device__ __forceinline__ void hgrn_pass1(const bf16* h, const float* lbraw, int layer, float* US, float* DD, char* lds, int wg, int G) {
    const int tid = tid_opaque(), lane = tid & 63, wid = __builtin_amdgcn_readfirstlane(tid >> 6), li = lane & 15, g = lane >> 4, half = wid >> 2, hw = wid & 3;
    char* L = lds + half * 43008; float* TOT = (float*)(L + 40960);
    const int ht = tid & 255, k = ht & 127, seg2 = ht >> 7;
    for (int pair = wg; pair < 256; pair += G) {
        const int item = 2 * pair + half, c = item & 63, bh = item >> 6, hh = bh & 3, b = bh >> 2; const size_t m0 = (size_t)b * SEQ + c * 64 + 32 * seg2;
        const bf16* hp = h + m0 * NH + hh * 128 + k;
        bf16 fzv[32], ivv[32];
#pragma unroll
        for (int i = 0; i < 32; ++i) { fzv[i] = hp[(size_t)i * NH + C_BF]; ivv[i] = hp[(size_t)i * NH + C_BI]; }
        const float lb = hg_lb(lbraw, layer, hh * 128 + k);
        float bl[32], kk[32], run = 0.f;
#pragma unroll
        for (int i = 0; i < 32; ++i) { float gl; hg_gate(bf1(fzv[i]), lb, gl, kk[i]); run += gl; bl[i] = run; }
        TOT[seg2 * 128 + k] = run;
        { v4u w[4];
#pragma unroll
          for (int i = 0; i < 32; i += 2) w[i >> 3][(i >> 1) & 3] = (unsigned)ivv[i] | ((unsigned)ivv[i + 1] << 16);
#pragma unroll
          for (int j = 0; j < 4; ++j) *(v4u*)(L + 20480 + k * 160 + seg2 * 64 + j * 16) = w[j]; }
        __syncthreads();
        const float tot0 = TOT[k], tot1 = TOT[128 + k], b63 = tot0 + tot1, base = b63 - (seg2 ? tot0 : 0.f);
        { v4u w[4];
#pragma unroll
          for (int i = 0; i < 32; i += 2) w[i >> 3][(i >> 1) & 3] = pk2(kk[i] * __expf(base - bl[i]), kk[i + 1] * __expf(base - bl[i + 1]));
#pragma unroll
          for (int j = 0; j < 4; ++j) *(v4u*)(L + k * 160 + seg2 * 64 + j * 16) = w[j]; }
        if (seg2 == 0) DD[item * 128 + k] = __expf(b63);
        __syncthreads();
#pragma unroll
        for (int mbi = 0; mbi < 2; ++mbi) { const int mb = 2 * hw + mbi;
            pg8::f32x4 acc[8];
#pragma unroll
            for (int nb = 0; nb < 8; ++nb) acc[nb] = (pg8::f32x4){0.f, 0.f, 0.f, 0.f};
#pragma unroll
            for (int ks = 0; ks < 2; ++ks) { const hbf16x8 af = *(const hbf16x8*)(L + (16 * mb + li) * 160 + ks * 64 + g * 16);
#pragma unroll
                for (int nb = 0; nb < 8; ++nb) { const hbf16x8 bb = *(const hbf16x8*)(L + 20480 + (16 * nb + li) * 160 + ks * 64 + g * 16); acc[nb] = __builtin_amdgcn_mfma_f32_16x16x32_bf16(af, bb, acc[nb], 0, 0, 0); } }
#pragma unroll
            for (int nb = 0; nb < 8; ++nb) *(pg8::f32x4*)(US + (size_t)item * 16384 + (16 * nb + li) * 128 + 16 * mb + 4 * g) = acc[nb]; }
        __syncthreads();
    }
}
__device__ __forceinline__ void hgrn_scan(const float* US, const float* DD, bf16* SB, int gtid, int gstride) {
    for (int e = gtid; e < 8 * 16384; e += gstride) { const int chain = e >> 14, idx = e & 16383, k = idx & 127; float run = 0.f;
        for (int c0 = 0; c0 < 64; c0 += 16) { float u[16], d[16];
#pragma unroll
            for (int j = 0; j < 16; ++j) { u[j] = US[(size_t)(chain * 64 + c0 + j) * 16384 + idx]; d[j] = DD[(chain * 64 + c0 + j) * 128 + k]; }
#pragma unroll
            for (int j = 0; j < 16; ++j) { SB[(size_t)(chain * 64 + c0 + j) * 16384 + idx] = (bf16)f2bf(run); run = d[j] * run + u[j]; } } }
}
constexpr int H3_QH = 0, H3_QT = 18432, H3_KT = 36864, H3_IVT = 82944, H3_AM = 103424, H3_TOT = 113664, H3_SS = 115712;
__device__ __forceinline__ void hgrn_pass3(const bf16* h, const float* lbraw, int layer, const bf16* SB, const float* ng, bf16* ycat, char* lds, int wg, int G) {
    const int tid = tid_opaque(), lane = tid & 63, wid = __builtin_amdgcn_readfirstlane(tid >> 6), li = lane & 15, g = lane >> 4;
    const int k = tid & 127, seg = tid >> 7, tb = wid & 3, vh = wid >> 2;
    float* TOT = (float*)(lds + H3_TOT); float* SS = (float*)(lds + H3_SS);
    for (int item = wg; item < 512; item += G) {
        const int c = item & 63, bh = item >> 6, hh = bh & 3, b = bh >> 2; const size_t m0 = (size_t)b * SEQ + c * 64;
        const bf16* hp = h + (m0 + 16 * seg) * NH + hh * 128 + k;
        bf16 fzv[16], qv[16], ivv[16];
#pragma unroll
        for (int i = 0; i < 16; ++i) { fzv[i] = hp[(size_t)i * NH + C_BF]; qv[i] = hp[(size_t)i * NH + C_BQ]; ivv[i] = hp[(size_t)i * NH + C_BI]; }
        hbf16x8 sbf[4][4];
#pragma unroll
        for (int ks = 0; ks < 4; ++ks)
#pragma unroll
            for (int nb = 0; nb < 4; ++nb) sbf[ks][nb] = *(const hbf16x8*)(SB + (size_t)item * 16384 + (16 * (vh * 4 + nb) + li) * 128 + ks * 32 + 8 * g);
        v2u gate[4];
#pragma unroll
        for (int nb = 0; nb < 4; ++nb) gate[nb] = *(const v2u*)(h + (m0 + 16 * tb + li) * NH + C_GB + hh * 128 + 16 * (vh * 4 + nb) + 4 * g);
        const float lb = hg_lb(lbraw, layer, hh * 128 + k);
        float bl[16], kk[16], run = 0.f;
#pragma unroll
        for (int i = 0; i < 16; ++i) { float gl; hg_gate(bf1(fzv[i]), lb, gl, kk[i]); run += gl; bl[i] = run; }
        TOT[seg * 128 + k] = run;
        { v4u w[2];
#pragma unroll
          for (int i = 0; i < 16; i += 2) w[i >> 3][(i >> 1) & 3] = (unsigned)ivv[i] | ((unsigned)ivv[i + 1] << 16);
          *(v4u*)(lds + H3_IVT + k * 160 + seg * 32) = w[0]; *(v4u*)(lds + H3_IVT + k * 160 + seg * 32 + 16) = w[1]; }
        __syncthreads();
        float pre[4]; pre[0] = 0.f; pre[1] = TOT[k]; pre[2] = pre[1] + TOT[128 + k]; pre[3] = pre[2] + TOT[256 + k];
        const float mypre = (seg == 0) ? 0.f : (seg == 1) ? pre[1] : (seg == 2) ? pre[2] : pre[3];
#pragma unroll
        for (int i = 0; i < 16; ++i) { const int t = 16 * seg + i; const float qraw = bf1(qv[i]);
            *(bf16*)(lds + H3_QT + t * 288 + k * 2) = (bf16)f2bf(qraw * __expf(bl[i])); *(bf16*)(lds + H3_QH + t * 288 + k * 2) = (bf16)f2bf(qraw * __expf(mypre + bl[i]));
#pragma unroll
            for (int I = 0; I < 4; ++I) if (I >= seg) { const int rowoff = (I == 0) ? 0 : (I == 1) ? 16 : (I == 2) ? 48 : 96;
                *(bf16*)(lds + H3_KT + (rowoff + t) * 288 + k * 2) = (bf16)f2bf(kk[i] * __expf(fminf(pre[I] - (mypre + bl[i]), 80.f))); } }
        __syncthreads();
        for (int rep = 0; rep < 2; ++rep) {
            int I = -1, J = 0; bool zero = false;
            if (rep == 0) { if (wid == 0) { I = 0; J = 0; } else if (wid == 1) { I = 1; J = 0; } else if (wid == 2) { I = 1; J = 1; } else if (wid == 3) { I = 2; J = 0; } else if (wid == 4) { I = 2; J = 1; } else if (wid == 5) { I = 2; J = 2; }
                            else if (wid == 6) { I = 0; J = 1; zero = true; } else { I = 2; J = 3; zero = true; } }
            else if (wid < 4) { I = 3; J = wid; }
            if (I < 0) continue;
            pg8::f32x4 acc = (pg8::f32x4){0.f, 0.f, 0.f, 0.f};
            if (!zero) { const int rowoff = (I == 0) ? 0 : (I == 1) ? 16 : (I == 2) ? 48 : 96;
#pragma unroll
                for (int ks = 0; ks < 4; ++ks) { const hbf16x8 af = *(const hbf16x8*)(lds + H3_QT + (16 * I + li) * 288 + ks * 64 + g * 16), bb = *(const hbf16x8*)(lds + H3_KT + (rowoff + 16 * J + li) * 288 + ks * 64 + g * 16);
                    acc = __builtin_amdgcn_mfma_f32_16x16x32_bf16(af, bb, acc, 0, 0, 0); } }
#pragma unroll
            for (int r = 0; r < 4; ++r) { const float v = (I == J && li > 4 * g + r) ? 0.f : acc[r]; *(bf16*)(lds + H3_AM + (16 * I + 4 * g + r) * 160 + (16 * J + li) * 2) = (bf16)f2bf(v); }
        }
        __syncthreads();
        pg8::f32x4 oacc[4];
#pragma unroll
        for (int nb = 0; nb < 4; ++nb) oacc[nb] = (pg8::f32x4){0.f, 0.f, 0.f, 0.f};
        for (int ks = 0; ks < ((tb < 2) ? 1 : 2); ++ks) { const hbf16x8 af = *(const hbf16x8*)(lds + H3_AM + (16 * tb + li) * 160 + ks * 64 + g * 16);
#pragma unroll
            for (int nb = 0; nb < 4; ++nb) { const hbf16x8 bb = *(const hbf16x8*)(lds + H3_IVT + (16 * (vh * 4 + nb) + li) * 160 + ks * 64 + g * 16); oacc[nb] = __builtin_amdgcn_mfma_f32_16x16x32_bf16(bb, af, oacc[nb], 0, 0, 0); } }
#pragma unroll
        for (int ks = 0; ks < 4; ++ks) { const hbf16x8 af = *(const hbf16x8*)(lds + H3_QH + (16 * tb + li) * 288 + ks * 64 + g * 16);
#pragma unroll
            for (int nb = 0; nb < 4; ++nb) oacc[nb] = __builtin_amdgcn_mfma_f32_16x16x32_bf16(sbf[ks][nb], af, oacc[nb], 0, 0, 0); }
        { float q = 0.f;
#pragma unroll
          for (int nb = 0; nb < 4; ++nb)
#pragma unroll
              for (int r = 0; r < 4; ++r) q += oacc[nb][r] * oacc[nb][r];
          q += __shfl_xor(q, 16); q += __shfl_xor(q, 32);
          if (g == 0) SS[(16 * tb + li) * 2 + vh] = q; }
        __syncthreads();
        { const int t = 16 * tb + li; const float rsn = rsqrtf((SS[t * 2] + SS[t * 2 + 1]) * (1.f / 128.f) + RMS_EPS);
          bf16* yp = ycat + (m0 + t) * DM + Y_B + hh * 128 + 4 * g; const float* ngp = ng + hh * 128 + 4 * g;
#pragma unroll
          for (int nb = 0; nb < 4; ++nb) { const int v0 = 16 * (vh * 4 + nb); const pg8::f32x4 nv = *(const pg8::f32x4*)(ngp + v0); const v2u gt = gate[nb];
              v2u w; w.x = pk2(oacc[nb][0] * rsn * nv[0] * __uint_as_float(gt.x << 16), oacc[nb][1] * rsn * nv[1] * __uint_as_float(gt.x & 0xffff0000u));
              w.y = pk2(oacc[nb][2] * rsn * nv[2] * __uint_as_float(gt.y << 16), oacc[nb][3] * rsn * nv[3] * __uint_as_float(gt.y & 0xffff0000u));
              *(v2u*)(yp + v0) = w; } }
        __syncthreads();
    }
}
__device__ __forceinline__ void mix_attn_naive(const bf16* h, float* atmp, int gw, int ngw, int lane) {
    for (int item = gw; item < NB * 4 * 64 * 8; item += ngw) {
        const int sl = item & 3, st = (item >> 2) & 1, bh = (item >> 3) & 7, qb = 63 - (item >> 6);
        const int b = bh >> 2, hh = bh & 3, q0 = qb * 64, row = q0 + lane;
        float q[64];
        { const bf16* qp = h + (size_t)(b * SEQ + row) * NH + C_CQ + hh * 128 + st * 64;
#pragma unroll
          for (int j = 0; j < 8; ++j) { const v4u w = *(const v4u*)(qp + 8 * j);
#pragma unroll
              for (int e = 0; e < 8; ++e) q[8 * j + e] = bfe(w, e) * 0.125f; } }
        float O[32], mx = -1e30f, l = 0.f;
#pragma unroll
        for (int j = 0; j < 32; ++j) O[j] = 0.f;
        for (int key = 0; key < q0 + 64; ++key) {
            const bf16* kp = h + (size_t)(b * SEQ + key) * NH + C_CK + hh * 128 + st * 64;
            float sc = 0.f;
#pragma unroll
            for (int j = 0; j < 8; ++j) { const v4u w = *(const v4u*)(kp + 8 * j);
#pragma unroll
                for (int e = 0; e < 8; ++e) sc += q[8 * j + e] * bfe(w, e); }
            if (key <= row) {
                const float mn = fmaxf(mx, sc), cf = __expf(mx - mn), pp = __expf(sc - mn);
                l = l * cf + pp; mx = mn;
                const bf16* vp = h + (size_t)(b * SEQ + key) * NH + C_CV + hh * 128 + sl * 32;
#pragma unroll
                for (int j = 0; j < 4; ++j) { const v4u w = *(const v4u*)(vp + 8 * j);
#pragma unroll
                    for (int e = 0; e < 8; ++e) O[8 * j + e] = O[8 * j + e] * cf + pp * bfe(w, e); }
            }
        }
        const float il = 1.f / l;
        float* op = atmp + ((size_t)st * MT + (b * SEQ + row)) * GW + hh * 128 + sl * 32;
#pragma unroll
        for (int j = 0; j < 8; ++j) *(f32x4*)(op + 4 * j) = (f32x4){O[4 * j] * il, O[4 * j + 1] * il, O[4 * j + 2] * il, O[4 * j + 3] * il};
    }
}
__device__ __forceinline__ float diff_lam(const float* dl  , int layer) {
    float s1 = 0.f, s2 = 0.f;
    for (int j = 0; j < 64; ++j) { s1 += dl[j] * dl[64 + j]; s2 += dl[128 + j] * dl[192 + j]; }
    const float lam_init = 0.8f - 0.6f * expf(-0.3f * (float)layer);
    return expf(s1) - expf(s2) + lam_init;
}
__device__ __forceinline__ float xmax16_32(float v) {
    auto a = __builtin_amdgcn_permlane16_swap(__float_as_uint(v), __float_as_uint(v), false, false); v = fmaxf(__uint_as_float(a[0]), __uint_as_float(a[1]));
    auto b = __builtin_amdgcn_permlane32_swap(__float_as_uint(v), __float_as_uint(v), false, false); return fmaxf(__uint_as_float(b[0]), __uint_as_float(b[1])); }
__device__ __forceinline__ float xsum16_32(float v) {
    auto a = __builtin_amdgcn_permlane16_swap(__float_as_uint(v), __float_as_uint(v), false, false); v = __uint_as_float(a[0]) + __uint_as_float(a[1]);
    auto b = __builtin_amdgcn_permlane32_swap(__float_as_uint(v), __float_as_uint(v), false, false); return __uint_as_float(b[0]) + __uint_as_float(b[1]); }
typedef short bf16x8_t __attribute__((ext_vector_type(8)));
template <bool DO_S, bool DO_PV, bool DIAG>
__device__ __forceinline__ void attn_step(const char* Ks, const char* Vs, const bf16x8_t (&qf)[2], bf16x8_t (&pf)[2], pg8::f32x4 (&oacc)[8], float& mrun, float& lsum, bool diag, int rs, int li, int g) {
    constexpr int KROW = 160; constexpr float SC = 0.125f * 1.4426950408889634f;
    const char* kp = Ks + li * KROW + g * 16; const char* vp = Vs + li * KROW + g * 16;
    pg8::f32x4 sacc[4];
    if (DO_S) {
        bf16x8_t kf[8];
#pragma unroll
        for (int i = 0; i < 8; ++i) kf[i] = *(const bf16x8_t*)(kp + (i >> 1) * 16 * KROW + (i & 1) * 64);
#pragma unroll
        for (int kb = 0; kb < 4; ++kb) { sacc[kb] = __builtin_amdgcn_mfma_f32_16x16x32_bf16(kf[2 * kb], qf[0], (pg8::f32x4){0.f, 0.f, 0.f, 0.f}, 0, 0, 0); sacc[kb] = __builtin_amdgcn_mfma_f32_16x16x32_bf16(kf[2 * kb + 1], qf[1], sacc[kb], 0, 0, 0); }
    }
    bf16x8_t vf[16];
    if (DO_PV) {
#pragma unroll
        for (int i = 0; i < 16; ++i) vf[i] = *(const bf16x8_t*)(vp + (i >> 1) * 16 * KROW + (i & 1) * 64);
    }
    __builtin_amdgcn_sched_barrier(0);
    const bf16x8_t p0 = pf[0], p1 = pf[1];
    if (DO_PV) {
#pragma unroll
        for (int i = 0; i < 16; ++i) oacc[i >> 1] = __builtin_amdgcn_mfma_f32_16x16x32_bf16(vf[i], (i & 1) ? p1 : p0, oacc[i >> 1], 0, 0, 0);
    }
    float alpha = 1.f; bool grow = false;
    if (DO_S) {
        float mx = -INFINITY;
#pragma unroll
        for (int kb = 0; kb < 4; ++kb)
#pragma unroll
            for (int r = 0; r < 4; ++r) { float sv = sacc[kb][r]; if (DIAG && (16 * kb + 4 * g + r) > (16 * rs + li)) sv = -INFINITY; sacc[kb][r] = sv; mx = fmaxf(mx, sv); }
        mx = xmax16_32(mx);
        grow = mx > mrun + 8.0f / SC; const float mnew = grow ? mx : mrun; alpha = __builtin_amdgcn_exp2f((mrun - mnew) * SC); mrun = mnew;
        const float nm = -mnew * SC; pg8::f32x4 psv = (pg8::f32x4){0.f, 0.f, 0.f, 0.f};
#pragma unroll
        for (int kb = 0; kb < 4; ++kb) { pg8::f32x4 tt = sacc[kb] * SC + nm;
            tt[0] = __builtin_amdgcn_exp2f(tt[0]); tt[1] = __builtin_amdgcn_exp2f(tt[1]); tt[2] = __builtin_amdgcn_exp2f(tt[2]); tt[3] = __builtin_amdgcn_exp2f(tt[3]); sacc[kb] = tt; psv += tt; }
        const float ps = (psv[0] + psv[1]) + (psv[2] + psv[3]);
        lsum = lsum * alpha + ps;
#pragma unroll
        for (int ks = 0; ks < 2; ++ks) { v4u w; w.x = pg8::cvt_pk_bf16(sacc[2 * ks][0], sacc[2 * ks][1]); w.y = pg8::cvt_pk_bf16(sacc[2 * ks][2], sacc[2 * ks][3]);
            w.z = pg8::cvt_pk_bf16(sacc[2 * ks + 1][0], sacc[2 * ks + 1][1]); w.w = pg8::cvt_pk_bf16(sacc[2 * ks + 1][2], sacc[2 * ks + 1][3]); pf[ks] = __builtin_bit_cast(bf16x8_t, w); }
    }
    if (DO_S && DO_PV) {
#pragma unroll
        for (int i = 0; i < 16; ++i) { __builtin_amdgcn_sched_group_barrier(0x008, 1, 0); __builtin_amdgcn_sched_group_barrier(0x002, 7, 0); }
    }
    __builtin_amdgcn_sched_barrier(0);
    if (DO_S) { if (__any(grow)) {
#pragma unroll
        for (int i = 0; i < 8; ++i) oacc[i] = oacc[i] * alpha; }
    }
}
__device__ __forceinline__ void mix_attn(const bf16* h, const bf16* VT, const float* dl, int layer, const float* ng, bf16* ycat, char* lds, int wg, int G) {
    const int tid = tid_opaque(), lane = tid & 63, wid = __builtin_amdgcn_readfirstlane(tid >> 6), rs = wid & 3, st = wid >> 2, li = lane & 15, g = lane >> 4;
    const float lam = diff_lam(dl, layer), lam_init = 0.8f - 0.6f * expf(-0.3f * (float)layer);
    constexpr int KROW = 160, TB = 40960, K2OFF = 10240, VOFF = 20480;
    for (int c = wg; c < 256; c += G) {
        const int bh = c & 7, j = c >> 3, b = bh >> 2, hh = bh & 3;
        const size_t mrow0 = (size_t)b * SEQ;
        for (int half = 0; half < 2; ++half) {
            const int qb = half ? j : 63 - j, q0 = qb * 64;
            bf16x8_t qf[2];
            { const GAS bf16* qp = (const GAS bf16*)h + (mrow0 + q0 + 16 * rs + li) * NH + C_CQ + hh * 128 + st * 64 + 8 * g;
              qf[0] = *(const GAS bf16x8_t*)qp; qf[1] = *(const GAS bf16x8_t*)(qp + 32); }
            const GAS bf16* gsrc[4]; int ldst[4];
#pragma unroll
            for (int i = 0; i < 2; ++i) { const int cidx = tid + 512 * i, row = cidx >> 4, ch = cidx & 15;
                gsrc[i] = (const GAS bf16*)h + (mrow0 + row) * NH + C_CK + hh * 128 + ch * 8; ldst[i] = (ch < 8 ? 0 : K2OFF) + row * KROW + (ch & 7) * 16; }
#pragma unroll
            for (int i = 2; i < 4; ++i) { const int c2 = tid + 512 * (i - 2), row = c2 >> 3, ch = c2 & 7, cc = ch & 3;
                gsrc[i] = (const GAS bf16*)VT + (size_t)(hh * 128 + row) * MT + mrow0 + ch * 8; ldst[i] = VOFF + row * KROW + ((ch >> 2) * 32 + (cc & 1) * 16 + (cc >> 1) * 4) * 2; }
            v4u stA[4];
#define ATT_LOAD(S, t) do { S[0] = *(const GAS v4u*)(gsrc[0] + (size_t)(t) * 64 * NH); S[1] = *(const GAS v4u*)(gsrc[1] + (size_t)(t) * 64 * NH); S[2] = *(const GAS v4u*)(gsrc[2] + (t) * 64); S[3] = *(const GAS v4u*)(gsrc[3] + (t) * 64); } while (0)
#define ATT_STORE(S, boff) do { _Pragma("unroll") for (int i_ = 0; i_ < 2; ++i_) *(v4u*)(lds + (boff) + ldst[i_]) = S[i_]; \
    _Pragma("unroll") for (int i_ = 2; i_ < 4; ++i_) { v2u lo_, hi_; lo_.x = S[i_].x; lo_.y = S[i_].y; hi_.x = S[i_].z; hi_.y = S[i_].w; *(v2u*)(lds + (boff) + ldst[i_]) = lo_; *(v2u*)(lds + (boff) + ldst[i_] + 16) = hi_; } } while (0)
            int b0 = 0, b1 = TB, b2 = 2 * TB;
            ATT_LOAD(stA, 0); ATT_STORE(stA, b0);
            if (qb >= 1) ATT_LOAD(stA, 1);
            __syncthreads();
            pg8::f32x4 oacc[8];
#pragma unroll
            for (int i = 0; i < 8; ++i) oacc[i] = (pg8::f32x4){0.f, 0.f, 0.f, 0.f};
            float mrun = -INFINITY, lsum = 0.f; bf16x8_t pf[2];
            if (qb == 0) attn_step<true, false, true>(lds + b0 + st * K2OFF, lds + b0 + VOFF, qf, pf, oacc, mrun, lsum, true, rs, li, g);
            else attn_step<true, false, false>(lds + b0 + st * K2OFF, lds + b0 + VOFF, qf, pf, oacc, mrun, lsum, false, rs, li, g);
            if (qb >= 1) ATT_STORE(stA, b1);
            __syncthreads();
            for (int t = 0; t < qb; ++t) {
                if (t + 2 <= qb) ATT_LOAD(stA, t + 2);
                if (t + 1 == qb) attn_step<true, true, true>(lds + b1 + st * K2OFF, lds + b0 + VOFF, qf, pf, oacc, mrun, lsum, true, rs, li, g);
                else attn_step<true, true, false>(lds + b1 + st * K2OFF, lds + b0 + VOFF, qf, pf, oacc, mrun, lsum, false, rs, li, g);
                if (t + 2 <= qb) ATT_STORE(stA, b2);
                __syncthreads();
                const int tmp = b0; b0 = b1; b1 = b2; b2 = tmp;
            }
            attn_step<false, true, false>(lds + b0 + st * K2OFF, lds + b0 + VOFF, qf, pf, oacc, mrun, lsum, false, rs, li, g);
#undef ATT_LOAD
#undef ATT_STORE
            float* X = (float*)(lds + b1);
            lsum += __shfl_xor(lsum, 16); lsum += __shfl_xor(lsum, 32);
            const float inv = 1.f / lsum;
            if (st == 1) {
#pragma unroll
                for (int blk = 0; blk < 8; ++blk)
#pragma unroll
                    for (int r = 0; r < 4; ++r) X[(rs * 32 + blk * 4 + r) * 64 + lane] = oacc[blk][r] * (inv * lam);
            }
            __syncthreads();
            if (st == 0) {
                float ss = 0.f;
#pragma unroll
                for (int blk = 0; blk < 8; ++blk)
#pragma unroll
                    for (int r = 0; r < 4; ++r) { const float o = oacc[blk][r] * inv - X[(rs * 32 + blk * 4 + r) * 64 + lane]; oacc[blk][r] = o; ss += o * o; }
                ss += __shfl_xor(ss, 16); ss += __shfl_xor(ss, 32);
                const float rsc = rsqrtf(ss * (1.f / 128.f) + RMS_EPS) * (1.f - lam_init);
                const size_t m = mrow0 + q0 + 16 * rs + li;
                const GAS bf16* gp = (const GAS bf16*)h + m * NH + C_GC + hh * 128 + 4 * g; GAS bf16* yp = (GAS bf16*)ycat + m * DM + Y_C + hh * 128 + 4 * g; const GAS float* ngp = (const GAS float*)ng + hh * 128 + 4 * g;
#pragma unroll
                for (int blk = 0; blk < 8; ++blk) { const v2u gt = *(const GAS v2u*)(gp + 16 * blk); const pg8::f32x4 nv = *(const GAS pg8::f32x4*)(ngp + 16 * blk);
                    v2u w; w.x = pk2(oacc[blk][0] * rsc * nv[0] * __uint_as_float(gt.x << 16), oacc[blk][1] * rsc * nv[1] * __uint_as_float(gt.x & 0xffff0000u));
                    w.y = pk2(oacc[blk][2] * rsc * nv[2] * __uint_as_float(gt.y << 16), oacc[blk][3] * rsc * nv[3] * __uint_as_float(gt.y & 0xffff0000u));
                    *(GAS v2u*)(yp + 16 * blk) = w; }
            }
            __syncthreads();
        }
    }
}
__device__ __forceinline__ void mix_attn_combine(const bf16* h, const float* atmp, const float* dl, int layer, const float* ng, bf16* ycat, int gw, int ngw, int lane) {
    const float lam = diff_lam(dl, layer), lam_init = 0.8f - 0.6f * expf(-0.3f * (float)layer);
    for (int item = gw; item < MT * 4; item += ngw) {
        const int hh = item & 3, m = item >> 2;
        const float* a1 = atmp + (size_t)m * GW + hh * 128, *a2 = atmp + ((size_t)MT + m) * GW + hh * 128;
        const float o0 = a1[lane] - lam * a2[lane], o1 = a1[64 + lane] - lam * a2[64 + lane];
        const float rs = rsqrtf(wave_sum(o0 * o0 + o1 * o1) * (1.f / 128.f) + RMS_EPS) * (1.f - lam_init);
        const bf16* hr = h + (size_t)m * NH + C_GC + hh * 128; bf16* yr = ycat + (size_t)m * DM + Y_C + hh * 128;
        yr[lane] = (bf16)f2bf(o0 * rs * ng[hh * 128 + lane] * bf1(hr[lane])); yr[64 + lane] = (bf16)f2bf(o1 * rs * ng[hh * 128 + 64 + lane] * bf1(hr[64 + lane]));
    }
}
__device__ __forceinline__ void ln_rows(float* z, const float* g, const float* bta, bf16* xlnb, int gw, int ngw, int lane) {
    for (int m = gw; m < MT; m += ngw) {
        f32x4* zr = (f32x4*)(z + (size_t)m * DM) + lane; f32x4 v[8]; float s = 0.f;
#pragma unroll
        for (int j = 0; j < 8; ++j) { v[j] = zr[64 * j]; s += (v[j][0] + v[j][1]) + (v[j][2] + v[j][3]); }
        const float mean = wave_sum(s) * (1.f / DM); float s2 = 0.f;
#pragma unroll
        for (int j = 0; j < 8; ++j) { v[j] = v[j] - mean; s2 += (v[j][0] * v[j][0] + v[j][1] * v[j][1]) + (v[j][2] * v[j][2] + v[j][3] * v[j][3]); }
        const float rstd = rsqrtf(wave_sum(s2) * (1.f / DM) + LN_EPS);
        v2u* o8 = (v2u*)(xlnb + (size_t)m * DM) + lane;
#pragma unroll
        for (int j = 0; j < 8; ++j) { const f32x4 gg = ((const f32x4*)g)[64 * j + lane], bb = ((const f32x4*)bta)[64 * j + lane]; const f32x4 y = v[j] * rstd * gg + bb;
            zr[64 * j] = y; v2u w; w.x = pk2(y[0], y[1]); w.y = pk2(y[2], y[3]); o8[64 * j] = w; }
    }
}

constexpr int N_PHASES = 1 + DEPTH * 6;
__global__ void __launch_bounds__(512, 2) mk_fwd(Args args) {
    extern __shared__ __attribute__((aligned(16))) unsigned char lds[];
    cg::grid_group grid = cg::this_grid();
    const int G = gridDim.x, wg = blockIdx.x;
    volatile LAS unsigned* MISC = (volatile LAS unsigned*)((LAS unsigned char*)lds + (LDS_BYTES - 64));
    if (threadIdx.x < 16) MISC[threadIdx.x] = 0u;
    __syncthreads();
    XcdBarrier xbar = xcd_barrier_post((unsigned*)args.ws, MISC);
#define TIDS() const int tid = tid_opaque(), lane = tid & 63, wave = __builtin_amdgcn_readfirstlane(tid >> 6); const int gw = wg * 8 + wave, ngw = G * 8, gtid = wg * 512 + tid, gstride = G * 512; (void)lane; (void)gw; (void)ngw; (void)gtid; (void)gstride
#define PTRS() unsigned char* ws = args.ws; asm volatile("" : "+s"(ws)); \
    bf16* WinT = (bf16*)(ws + WS_WIN); bf16* WoutT = (bf16*)(ws + WS_WOUT); bf16* WpgT = (bf16*)(ws + WS_WPG); bf16* WpeT = (bf16*)(ws + WS_WPE); \
    bf16* XB = (bf16*)(ws + WS_XB); bf16* PB = (bf16*)(ws + WS_PB); bf16* PE = (bf16*)(ws + WS_PE); bf16* H = (bf16*)(ws + WS_H); bf16* VT = (bf16*)(ws + WS_VT); \
    bf16* YC = (bf16*)(ws + WS_YCAT); float* Z = (float*)(ws + WS_Z); bf16* XLNB = (bf16*)(ws + WS_XLNB); float* XF = args.out;   float* ATMP = (float*)(ws + WS_ATMP); float* US = (float*)(ws + WS_HS); bf16* SB = (bf16*)(ws + WS_SB); float* DD = (float*)(ws + WS_DD); float* C1 = (float*)(ws + 65536); float* C2 = (float*)(ws + 81920); float* STATS = (float*)(ws + 131072); (void)US; (void)SB; (void)DD; (void)C1; (void)C2; (void)STATS; \
    (void)WinT; (void)WoutT; (void)WpgT; (void)WpeT; (void)XB; (void)PB; (void)PE; (void)H; (void)VT; (void)YC; (void)Z; (void)XLNB; (void)XF; (void)ATMP
    const int lo = args.ph_lo, hi = args.ph_hi;
#define IN(k) (lo <= (k) && (k) < hi)
#define SEAM(k) do { if (IN(k) && IN((k) + 1)) xcd_barrier(xbar); } while (0)
    if (lo < 0) grid.sync();
    constexpr int I_IN = 32 * 120, I_O = 32 * 32, I_PE = 4 * 32, I_L = I_IN + 2 * I_O + I_PE;
#define CONVERT_ITEMS(lo_, hi_) do { TIDS(); PTRS(); float* scr = (float*)(lds + wave * 16640); \
        for (int it = (lo_) + gw; it < (hi_); it += ngw) { const int cl = it / I_L; int r = it % I_L; \
            if (r < I_IN) { p0_transpose_item(args.in[2] + (size_t)cl * DM * NH, DM, NH, WinT + (size_t)cl * NH * DM, scr, r, lane, nullptr, nullptr, nullptr, nullptr); continue; } r -= I_IN; \
            if (r < I_O) { p0_transpose_item(args.in[12] + (size_t)cl * DM * DM, DM, DM, WoutT + (size_t)cl * DM * DM, scr, r, lane, nullptr, nullptr, nullptr, nullptr); continue; } r -= I_O; \
            if (r < I_O) { p0_transpose_item(args.in[16] + (size_t)cl * DM * DM, DM, DM, WpgT + (size_t)cl * DM * DM, scr, r, lane, args.in[13] + cl * DM, args.in[14] + cl * DM, C1 + cl * DM, C2 + cl * DM); continue; } r -= I_O; \
            p0_transpose_item(args.in[15] + (size_t)cl * PLE * DM, PLE, DM, WpeT + (size_t)cl * DM * PLE, scr, r, lane, nullptr, nullptr, nullptr, nullptr); } } while (0)
#define FILL_SEAM(k, lo_, hi_, lo2_, hi2_) do { if (IN(k) && IN((k) + 1)) { if (l == 0 && DEPTH == 2) { xcd_barrier_arrive(xbar); CONVERT_ITEMS(I_L + (lo_), I_L + (hi_)); \
        if ((hi2_) > (lo2_)) CONVERT_ITEMS(I_L + (lo2_), I_L + (hi2_)); xcd_barrier_wait(xbar); } else xcd_barrier(xbar); } } while (0)
    if (IN(0) && !(DIS&128)) { CONVERT_ITEMS(0, I_L); }
    if (IN(0) && !(DIS&128)) { TIDS(); PTRS();
        for (int i0 = gtid; i0 < MT * DM / 4; i0 += 8 * gstride) { f32x4 v[8];
#pragma unroll
            for (int u = 0; u < 8; ++u) { const int i = i0 + u * gstride; if (i < MT * DM / 4) v[u] = ((const f32x4*)args.in[0])[i]; }
#pragma unroll
            for (int u = 0; u < 8; ++u) { const int i = i0 + u * gstride; if (i < MT * DM / 4) { v2u w; w.x = pk2(v[u][0], v[u][1]); w.y = pk2(v[u][2], v[u][3]); ((v2u*)XB)[i] = w; } } }
        for (int i0 = gtid; i0 < DEPTH * MT * PLE / 4; i0 += 8 * gstride) { f32x4 v[8];
#pragma unroll
            for (int u = 0; u < 8; ++u) { const int i = i0 + u * gstride; if (i < DEPTH * MT * PLE / 4) v[u] = ((const f32x4*)args.in[1])[i]; }
#pragma unroll
            for (int u = 0; u < 8; ++u) { const int i = i0 + u * gstride; if (i < DEPTH * MT * PLE / 4) { v2u w; w.x = pk2(v[u][0], v[u][1]); w.y = pk2(v[u][2], v[u][3]); ((v2u*)PB)[i] = w; } } }
    }
    if (IN(0) && IN(1)) { if (DEPTH == 2) { xcd_barrier_arrive(xbar); CONVERT_ITEMS(I_L, I_L + 1280); xcd_barrier_wait(xbar); } else xcd_barrier(xbar); }
#pragma nounroll
    for (int l = 0; l < DEPTH; ++l) {
        const int p1 = 1 + 6 * l;
        if (IN(p1) && !(DIS&64)) { PTRS();
            { pg8::Gemm g{XB, WinT + (size_t)l * NH * DM, MT, NH, DM}; pg8::SkipOrder S; S.init(MT, NH, G, wg, C_CV / 256, 2); pg8::EpiH E{H, NH, 1};
              pg8::gemm_phase<pg8::EpiH, pg8::SkipOrder, true, true>((PG8_LAS unsigned char*)lds, g, S, E); }
            { pg8::Gemm g{WinT + (size_t)l * NH * DM + (size_t)C_CV * DM, XB, GW, MT, DM}; pg8::StaticOrder S; S.init(GW, MT, G, (G == 256) ? (wg + 128) % 256 : wg); pg8::EpiH E{VT, MT, 0};
              pg8::gemm_phase<pg8::EpiH, pg8::StaticOrder, true, true>((PG8_LAS unsigned char*)lds, g, S, E); }
            { pg8::Gemm g{PB + (size_t)l * MT * PLE, WpeT + (size_t)l * DM * PLE, MT, DM, PLE}; pg8::StaticOrder S; if (G == 256) S.init(MT, DM, 64, wg >= 192 ? wg - 192 : (1 << 20)); else S.init(MT, DM, G, wg); pg8::EpiH E{PE, DM, 0};
              pg8::gemm_phase<pg8::EpiH, pg8::StaticOrder, true, true>((PG8_LAS unsigned char*)lds, g, S, E); }
        }
        FILL_SEAM(p1, 1280, 2560, 0, 0);
        if (IN(p1 + 1)) {
            if(!(DIS&1)) { PTRS(); hgrn_pass1(H, args.in[4], l, US, DD, (char*)lds, wg, G); }
            xcd_barrier_arrive(xbar);
            if(!(DIS&8)) { PTRS(); mix_attn(H, VT, args.in[6] + l * 256, l, args.in[7] + l * GW, YC, (char*)lds, wg, G); }
            xcd_barrier_wait(xbar);
            { TIDS(); PTRS(); hgrn_scan(US, DD, SB, gtid, gstride); }
            xcd_barrier_arrive(xbar);
            if(!(DIS&2)) { PTRS(); mix_sgu(H, args.in[8] + l * GW, args.in[9] + l * GW, args.in[10] + (size_t)l * 4 * 16384, args.in[11] + l * GW, YC, (char*)lds, wg, G); }
            if(!(DIS&4)) { TIDS(); PTRS(); mix_conv(H, args.in[3] + l * 3 * GW, YC, gtid, gstride); }
            xcd_barrier_wait(xbar);
        }
        if (IN(p1 + 3)) { PTRS(); hgrn_pass3(H, args.in[4], l, SB, args.in[5] + l * GW, YC, (char*)lds, wg, G); }
        FILL_SEAM(p1 + 3, 2560, I_IN, I_IN + 2 * I_O, I_L);
        if (IN(p1 + 4) && !(DIS&16)) { PTRS(); const float* xres = (l == 0) ? args.in[0] : XF; asm volatile("" : "+s"(xres));
            pg8::Gemm g{YC, WoutT + (size_t)l * DM * DM, MT, DM, DM}; pg8::StaticOrder S; S.init(MT, DM, G, wg); pg8::EpiZ E{xres, Z, XLNB, STATS + (size_t)l * MT * 2, DM, ALPHA};
            pg8::gemm_phase<pg8::EpiZ, pg8::StaticOrder, true, true>((PG8_LAS unsigned char*)lds, g, S, E);
        }
        FILL_SEAM(p1 + 4, I_IN, I_IN + I_O, 0, 0);
        if (IN(p1 + 5) && !(DIS&32)) { PTRS(); float* xout = (l == DEPTH - 1) ? args.out : XF; asm volatile("" : "+s"(xout));
            pg8::Gemm g{XLNB, WpgT + (size_t)l * DM * DM, MT, DM, DM}; pg8::StaticOrder S; S.init(MT, DM, G, wg); pg8::EpiPG E{XLNB, STATS + (size_t)l * MT * 2, C1 + l * DM, C2 + l * DM, args.in[13] + l * DM, args.in[14] + l * DM, PE, xout, (l == DEPTH - 1) ? (bf16*)nullptr : XB, DM};
            pg8::gemm_phase<pg8::EpiPG, pg8::StaticOrder, true, true>((PG8_LAS unsigned char*)lds, g, S, E);
        }
        if (l + 1 < DEPTH) FILL_SEAM(p1 + 5, I_IN + I_O, I_IN + 2 * I_O, 0, 0);
    }
#undef IN
#undef SEAM
}

extern "C" void kernel_launch(void* const* d_in, const int* in_sizes, int n_in, void* d_out, int out_size, void* d_ws, size_t ws_size, hipStream_t stream) {
    static int grid = 0;
    if (grid == 0) {
        if (n_in != 17 || out_size != MT * DM || ws_size < WS_END) { fprintf(stderr, "kernel_launch: unexpected shapes (n_in %d, out %d, ws %zu)\n", n_in, out_size, ws_size); grid = -1; return; }
        int dev = 0, cus = 0, per_cu = 0;
        hipGetDevice(&dev); hipDeviceGetAttribute(&cus, hipDeviceAttributeMultiprocessorCount, dev);
        hipFuncSetAttribute((const void*)mk_fwd, hipFuncAttributeMaxDynamicSharedMemorySize, LDS_BYTES);
        hipOccupancyMaxActiveBlocksPerMultiprocessor(&per_cu, (const void*)mk_fwd, 512, LDS_BYTES);
        if (per_cu < 1) { fprintf(stderr, "kernel_launch: occupancy query returned %d\n", per_cu); per_cu = 1; }
        (void)hipGetLastError();
        grid = cus * per_cu;
        fprintf(stderr, "kernel_launch: grid %d (cus %d x %d)\n", grid, cus, per_cu);
    }
    if (grid < 0) return;
    if (hipMemsetAsync(d_ws, 0, 262144, stream) != hipSuccess) { fprintf(stderr, "kernel_launch: memset failed\n"); return; }
    Args a{};
    for (int i = 0; i < 17; ++i) a.in[i] = (const float*)d_in[i];
    a.out = (float*)d_out; a.ws = (unsigned char*)d_ws;
#if MK_PER_PHASE
    for (int p = 0; p < N_PHASES; ++p) { a.ph_lo = p; a.ph_hi = p + 1; void* kargs[] = {&a};
        hipError_t e = hipLaunchCooperativeKernel((const void*)mk_fwd, dim3(grid), dim3(512), kargs, LDS_BYTES, stream);
        if (e != hipSuccess) { fprintf(stderr, "launch %d failed: %s\n", p, hipGetErrorString(e)); break; } }
#else
    a.ph_lo = 0; a.ph_hi = N_PHASES; void* kargs[] = {&a};
    hipError_t e = hipLaunchCooperativeKernel((const void*)mk_fwd, dim3(grid), dim3(512), kargs, LDS_BYTES, stream);
    if (e != hipSuccess) fprintf(stderr, "cooperative launch failed: %s (grid %d)\n", hipGetErrorString(e), grid);
#endif
}
```

```cpp
#include <hip/hip_runtime.h>
#include <cstdio>
#include <cstdint>
#include <hip/hip_cooperative_groups.h>
namespace cg = cooperative_groups;

namespace pg8 {
#define PG8_LAS __attribute__((address_space(3)))
typedef unsigned short bf16_t;
typedef short bf16x8 __attribute__((ext_vector_type(8)));
typedef float f32x4 __attribute__((ext_vector_type(4)));
typedef unsigned u32x4 __attribute__((ext_vector_type(4)));
constexpr int BM = 256, BK = 64, HALF = 128, HTB = HALF * BK * 2  , STAGE_BYTES = 8 * HTB, NXCD = 8, WGM = 8;

__host__ __device__ __forceinline__ int lds_byte(int r, int c) { const int st = (r >> 4) * 2 + (c >> 5), rr = r & 15, cc = c & 31, ob = rr * 64 + cc * 2; return st * 1024 + (ob ^ (((ob >> 9) & 1) << 5)); }
__host__ __device__ __forceinline__ void stage_rc(int b, int& R, int& C) { const int st = b / 1024, sb = b % 1024, swz = sb ^ (((sb >> 9) & 1) << 5); R = (st >> 1) * 16 + swz / 64; C = (st & 1) * 32 + (swz % 64) / 2; }
__host__ __device__ __forceinline__ int perm32(int rho) { const int n = rho >> 4, i = rho & 15; return 8 * (i >> 2) + 4 * n + (i & 3); }

struct Unit { int pm, pn; };
struct Gemm { const bf16_t* A; const bf16_t* Bt; int M, N, K; };

struct StaticOrder {
    int nM, nN, nwg, G, c;
    __host__ __device__ void init(int M, int N, int G_, int c_) { nM = M / BM; nN = N / BM; nwg = nM * nN; G = G_; c = c_; }
    __host__ __device__ bool next(int i, Unit& u) const {
        const long L = (long)i * G + c; if (L >= nwg) return false;
        int wgid = (int)L; { const int q = nwg / NXCD, r = nwg % NXCD, xcd = wgid % NXCD, off = wgid / NXCD; wgid = (xcd < r ? xcd * (q + 1) : r * (q + 1) + (xcd - r) * q) + off; }
        const int nig = WGM * nN, gid = wgid / nig, fm = gid * WGM, gsz = (nM - fm) < WGM ? (nM - fm) : WGM;
        u.pm = fm + ((wgid % nig) % gsz); u.pn = (wgid % nig) / gsz; return true;
    }
    __device__ __forceinline__ void a_ready(const Unit&) const {}
    __device__ __forceinline__ void done(const Unit&) const {}
};

struct SkipOrder {
    StaticOrder S; int skip0, nskip;
    __host__ __device__ void init(int M, int N, int G_, int c_, int skip0_, int nskip_) { S.init(M, N - nskip_ * BM, G_, c_); skip0 = skip0_; nskip = nskip_; }
    __host__ __device__ bool next(int i, Unit& u) const { if (!S.next(i, u)) return false; if (u.pn >= skip0) u.pn += nskip; return true; }
    __device__ __forceinline__ void a_ready(const Unit&) const {}
    __device__ __forceinline__ void done(const Unit&) const {}
};
__device__ __forceinline__ unsigned cvt_pk_bf16(float lo, float hi) { unsigned r; asm volatile("v_cvt_pk_bf16_f32 %0, %1, %2" : "=v"(r) : "v"(lo), "v"(hi)); return r; }
typedef unsigned u32x2 __attribute__((ext_vector_type(2)));
__device__ __forceinline__ float bf_lo(unsigned w) { return __uint_as_float(w << 16); }
__device__ __forceinline__ float bf_hi(unsigned w) { return __uint_as_float(w & 0xffff0000u); }
__device__ __forceinline__ float act_fn(float v, int act) {
    const float t = (act == 1) ? 1.5957691216057308f * (v + 0.044715f * v * v * v) : v;
    return v * __builtin_amdgcn_rcpf(1.f + __expf(-t));
}
struct EpiH {
    static constexpr bool PERM = true, AFTER_DRAIN = false;
    bf16_t* O; int ldc; int byblock;
    __device__ __forceinline__ void operator()(const f32x4 (&acc)[2][2][4][2], const Unit& u, int wr, int wc, int fr, int fq) const {
        int act = 0; if (byblock) { const int blk = u.pn >> 1; act = (blk == 9 || blk == 10) ? 1 : (blk >= 11 ? 2 : 0); }
        const int row0 = u.pm * BM + wr * 64 + fr, col0 = u.pn * BM + wc * 32 + 8 * fq;
#pragma unroll
        for (int ai = 0; ai < 2; ++ai)
#pragma unroll
            for (int m = 0; m < 4; ++m) { bf16_t* rowp = O + (size_t)(row0 + ai * HALF + m * 16) * ldc + col0;
#pragma unroll
                for (int bj = 0; bj < 2; ++bj) { f32x4 v0 = acc[ai][bj][m][0], v1 = acc[ai][bj][m][1];
                    if (act != 0) {
                        const float k0 = (act == 1) ? -1.5957691216057308f * 1.4426950408889634f : -1.4426950408889634f, k1 = (act == 1) ? -1.5957691216057308f * 0.044715f * 1.4426950408889634f : 0.f;
                        const f32x4 a0 = v0 * ((v0 * v0) * k1 + k0), a1 = v1 * ((v1 * v1) * k1 + k0); f32x4 r0, r1;
#pragma unroll
                        for (int e = 0; e < 4; ++e) { r0[e] = __builtin_amdgcn_rcpf(1.f + __builtin_amdgcn_exp2f(a0[e])); r1[e] = __builtin_amdgcn_rcpf(1.f + __builtin_amdgcn_exp2f(a1[e])); }
                        v0 = v0 * r0; v1 = v1 * r1; }
                    u32x4 w; w.x = cvt_pk_bf16(v0[0], v0[1]); w.y = cvt_pk_bf16(v0[2], v0[3]); w.z = cvt_pk_bf16(v1[0], v1[1]); w.w = cvt_pk_bf16(v1[2], v1[3]);
                    *(u32x4*)(rowp + bj * HALF) = w; } }
    }
};
__device__ __forceinline__ float sum_fq(float v) {
    auto a = __builtin_amdgcn_permlane16_swap(__float_as_uint(v), __float_as_uint(v), false, false); v = __uint_as_float(a[0]) + __uint_as_float(a[1]);
    auto b = __builtin_amdgcn_permlane32_swap(__float_as_uint(v), __float_as_uint(v), false, false); return __uint_as_float(b[0]) + __uint_as_float(b[1]); }
struct EpiZ {
    static constexpr bool PERM = true, AFTER_DRAIN = false;
    const float* X; float* Z; bf16_t* ZB; float* ST; int ldc; float alpha;
    __device__ __forceinline__ void operator()(const f32x4 (&acc)[2][2][4][2], const Unit& u, int wr, int wc, int fr, int fq) const {
        const int row0 = u.pm * BM + wr * 64 + fr, col0 = u.pn * BM + wc * 32 + 8 * fq;
#pragma unroll
        for (int ai = 0; ai < 2; ++ai)
#pragma unroll
            for (int m = 0; m < 4; ++m) { const int row = row0 + ai * HALF + m * 16; const size_t off = (size_t)row * ldc + col0; float s1 = 0.f, s2 = 0.f;
#pragma unroll
                for (int bj = 0; bj < 2; ++bj) { const size_t o2 = off + bj * HALF; const f32x4 x0 = *(const f32x4*)(X + o2), x1 = *(const f32x4*)(X + o2 + 4);
                    const f32x4 z0 = x0 * alpha + acc[ai][bj][m][0], z1 = x1 * alpha + acc[ai][bj][m][1];
                    u32x4 w; w.x = cvt_pk_bf16(z0[0], z0[1]); w.y = cvt_pk_bf16(z0[2], z0[3]); w.z = cvt_pk_bf16(z1[0], z1[1]); w.w = cvt_pk_bf16(z1[2], z1[3]); *(u32x4*)(ZB + o2) = w;
                    s1 += ((z0[0] + z0[1]) + (z0[2] + z0[3])) + ((z1[0] + z1[1]) + (z1[2] + z1[3]));
                    s2 += ((z0[0] * z0[0] + z0[1] * z0[1]) + (z0[2] * z0[2] + z0[3] * z0[3])) + ((z1[0] * z1[0] + z1[1] * z1[1]) + (z1[2] * z1[2] + z1[3] * z1[3])); }
                s1 = sum_fq(s1); s2 = sum_fq(s2);
                if (fq == 0) { atomicAdd(ST + 2 * row, s1); atomicAdd(ST + 2 * row + 1, s2); } }
    }
};
struct EpiPG {
    static constexpr bool PERM = true, AFTER_DRAIN = false;
    const bf16_t* Zb; const float* ST; const float* C1; const float* C2; const float* LG; const float* LB; const bf16_t* PE; float* OUTF; bf16_t* XB; int ldc;
    __device__ __forceinline__ void operator()(const f32x4 (&acc)[2][2][4][2], const Unit& u, int wr, int wc, int fr, int fq) const {
        const int row0 = u.pm * BM + wr * 64 + fr, col0 = u.pn * BM + wc * 32 + 8 * fq;
#pragma unroll
        for (int bj = 0; bj < 2; ++bj) { const int col = col0 + bj * HALF;
            f32x4 c1[2], c2[2], lg[2], lb[2];
#pragma unroll
            for (int n = 0; n < 2; ++n) { c1[n] = *(const f32x4*)(C1 + col + 4 * n); c2[n] = *(const f32x4*)(C2 + col + 4 * n); lg[n] = *(const f32x4*)(LG + col + 4 * n); lb[n] = *(const f32x4*)(LB + col + 4 * n); }
#pragma unroll
            for (int ai = 0; ai < 2; ++ai)
#pragma unroll
                for (int m = 0; m < 4; ++m) { const int row = row0 + ai * HALF + m * 16; const size_t o2 = (size_t)row * ldc + col;
                    const float s1 = ST[2 * row], s2 = ST[2 * row + 1], mu = s1 * (1.f / 2048.f), rstd = __builtin_amdgcn_rsqf(fmaxf(s2 * (1.f / 2048.f) - mu * mu, 0.f) + 1e-5f);
                    const u32x4 zw = *(const u32x4*)(Zb + o2), pw = *(const u32x4*)(PE + o2); u32x4 xw;
#pragma unroll
                    for (int n = 0; n < 2; ++n) { const unsigned za = n ? zw.z : zw.x, zb2 = n ? zw.w : zw.y, pa = n ? pw.z : pw.x, pb = n ? pw.w : pw.y;
                        const float zv[4] = {bf_lo(za), bf_hi(za), bf_lo(zb2), bf_hi(zb2)}, pv[4] = {bf_lo(pa), bf_hi(pa), bf_lo(pb), bf_hi(pb)}; const f32x4 a = acc[ai][bj][m][n]; f32x4 o;
#pragma unroll
                        for (int e = 0; e < 4; ++e) { const float sv = rstd * (a[e] - mu * c1[n][e]) + c2[n][e]; const float xl = (zv[e] - mu) * rstd * lg[n][e] + lb[n][e]; o[e] = xl + pv[e] * __builtin_amdgcn_rcpf(1.f + __expf(-sv)); }
                        *(f32x4*)(OUTF + o2 + 4 * n) = o; if (n == 0) { xw.x = cvt_pk_bf16(o[0], o[1]); xw.y = cvt_pk_bf16(o[2], o[3]); } else { xw.z = cvt_pk_bf16(o[0], o[1]); xw.w = cvt_pk_bf16(o[2], o[3]); } }
                    if (XB) *(u32x4*)(XB + o2) = xw; }
            asm volatile("" ::: "memory"); }
    }
};
template <class Epi, class Sched, bool ALIGN_EPI = false, bool SP2 = false>
__device__ __forceinline__ void gemm_phase(PG8_LAS unsigned char* lds, const Gemm g, const Sched& S, const Epi& E) {
    int tid_ = threadIdx.x; asm volatile("" : "+v"(tid_)); const int tid = tid_, wid = __builtin_amdgcn_readfirstlane(tid >> 6), lane = tid & 63, wr = wid >> 2, wc = wid & 3, fr = lane & 15, fq = lane >> 4;
    const int K = g.K, nt = K / BK;
    unsigned voffA[2], voffB[2];
#pragma unroll
    for (int i = 0; i < 2; ++i) { int R, C; stage_rc(tid * 16 + i * 8192, R, C); const int Rb = Epi::PERM ? ((R & ~31) + perm32(R & 31)) : R;
        voffA[i] = (unsigned)(R * K + C) * 2u; voffB[i] = (unsigned)(Rb * K + C) * 2u; }
    const size_t kstep = (size_t)(BK * 2);
    const size_t hstep = (size_t)HALF * K * 2;
    const size_t tstep = 2 * hstep;
    const unsigned ldsw = (unsigned)wid * 1024u;
    const int aoff = lds_byte(wr * 64 + fr, fq * 8), boff = lds_byte(wc * 32 + fr, fq * 8);
#define PG8_SA(b, h) (((b) * 2 + (h)) * HTB)
#define PG8_SB(b, h) ((4 + (b) * 2 + (h)) * HTB)
#define PG8_STAGE(bufoff, gbase, voff) do { _Pragma("unroll") for (int _i = 0; _i < 2; ++_i) \
        __builtin_amdgcn_global_load_lds((const unsigned*)((const char*)(gbase) + (voff)[_i]), (PG8_LAS unsigned*)(lds + (bufoff) + ldsw + _i * 8192), 16, 0, 0); } while (0)
#define PG8_LDA(dst, b, h) do { _Pragma("unroll") for (int m = 0; m < 4; ++m) _Pragma("unroll") for (int k = 0; k < 2; ++k) dst[m][k] = *(const PG8_LAS bf16x8*)(lds + PG8_SA(b, h) + aoff + m * 2048 + k * 1024); } while (0)
#define PG8_LDB(dst, b, h) do { _Pragma("unroll") for (int n = 0; n < 2; ++n) _Pragma("unroll") for (int k = 0; k < 2; ++k) dst[n][k] = *(const PG8_LAS bf16x8*)(lds + PG8_SB(b, h) + boff + n * 2048 + k * 1024); } while (0)
#define PG8_MMA(ai, bj, At, Bt) do { __builtin_amdgcn_s_setprio(1); _Pragma("unroll") for (int m = 0; m < 4; ++m) _Pragma("unroll") for (int n = 0; n < 2; ++n) _Pragma("unroll") for (int k = 0; k < 2; ++k) \
        acc[ai][bj][m][n] = __builtin_amdgcn_mfma_f32_16x16x32_bf16(Bt[n][k], At[m][k], acc[ai][bj][m][n], 0, 0, 0); __builtin_amdgcn_s_setprio(0); } while (0)
#define PG8_WAIT_V(n) asm volatile("s_waitcnt vmcnt(" #n ")" ::: "memory")
#define PG8_WAIT_L(n) asm volatile("s_waitcnt lgkmcnt(" #n ")" ::: "memory")
#define PG8_BAR __builtin_amdgcn_s_barrier()
#define PG8_SCHED __builtin_amdgcn_sched_barrier(0)
    Unit cur, nxt; int ui = 0;
    if (!S.next(0, cur)) return;
    f32x4 acc[2][2][4][2];
#pragma unroll
    for (int a = 0; a < 2; ++a)
#pragma unroll
        for (int b = 0; b < 2; ++b)
#pragma unroll
            for (int m = 0; m < 4; ++m)
#pragma unroll
                for (int n = 0; n < 2; ++n) acc[a][b][m][n] = (f32x4){0.f, 0.f, 0.f, 0.f};
    bf16x8 At[4][2], B0[2][2], B1[2][2];
    const char* cA = (const char*)g.A + (size_t)cur.pm * tstep; const char* cB = (const char*)g.Bt + (size_t)cur.pn * tstep;
    S.a_ready(cur);
    if constexpr (SP2) {
        PG8_STAGE(PG8_SB(0, 0), cB, voffB); PG8_STAGE(PG8_SB(0, 1), cB + hstep, voffB); PG8_STAGE(PG8_SA(0, 0), cA, voffA); PG8_STAGE(PG8_SA(0, 1), cA + hstep, voffA);
        if (wr == 1) PG8_BAR;
        PG8_WAIT_V(2); PG8_BAR;
        PG8_STAGE(PG8_SB(1, 0), cB + kstep, voffB); PG8_STAGE(PG8_SA(1, 0), cA + kstep, voffA); PG8_STAGE(PG8_SB(1, 1), cB + hstep + kstep, voffB);
        PG8_WAIT_V(6); PG8_BAR;
    } else {
        PG8_STAGE(PG8_SB(0, 0), cB, voffB); PG8_STAGE(PG8_SA(0, 0), cA, voffA); PG8_STAGE(PG8_SB(0, 1), cB + hstep, voffB); PG8_STAGE(PG8_SA(0, 1), cA + hstep, voffA);
        if (wr == 1) PG8_BAR;
        PG8_WAIT_V(4); PG8_BAR;
        PG8_STAGE(PG8_SB(1, 0), cB + kstep, voffB); PG8_STAGE(PG8_SA(1, 0), cA + kstep, voffA); PG8_STAGE(PG8_SB(1, 1), cB + hstep + kstep, voffB);
        PG8_WAIT_V(6); PG8_BAR;
    }
    for (;;) {
        const bool has_next = S.next(ui + 1, nxt);
        const char* nA = has_next ? (const char*)g.A + (size_t)nxt.pm * tstep : cA; const char* nB = has_next ? (const char*)g.Bt + (size_t)nxt.pn * tstep : cB;
        for (int t = 0; t < nt; t += 2) {
            const bool last = (t == nt - 2);
            const char* a1 = cA + (size_t)(t + 1) * kstep;
            const char* a2 = last ? nA : cA + (size_t)(t + 2) * kstep; const char* b2 = last ? nB : cB + (size_t)(t + 2) * kstep;
            const char* a3 = a2 + kstep; const char* b3 = b2 + kstep;
            if (last && has_next) S.a_ready(nxt);
            if constexpr (SP2) {
            PG8_LDB(B0, 0, 0); PG8_LDB(B1, 0, 1); PG8_SCHED; PG8_LDA(At, 0, 0); PG8_STAGE(PG8_SA(1, 1), a1 + hstep, voffA);
            PG8_WAIT_V(8); PG8_WAIT_L(0); PG8_BAR; PG8_MMA(0, 0, At, B0); PG8_MMA(0, 1, At, B1); PG8_BAR; PG8_SCHED;
            PG8_LDA(At, 0, 1); PG8_STAGE(PG8_SB(0, 0), b2, voffB); PG8_STAGE(PG8_SB(0, 1), b2 + hstep, voffB); PG8_STAGE(PG8_SA(0, 0), a2, voffA);
            PG8_WAIT_V(8); PG8_WAIT_L(0); PG8_BAR; PG8_MMA(1, 0, At, B0); PG8_MMA(1, 1, At, B1); PG8_BAR; PG8_SCHED;
            PG8_LDB(B0, 1, 0); PG8_LDB(B1, 1, 1); PG8_SCHED; PG8_LDA(At, 1, 0); PG8_STAGE(PG8_SA(0, 1), a2 + hstep, voffA);
            PG8_WAIT_V(8); PG8_WAIT_L(0); PG8_BAR; PG8_MMA(0, 0, At, B0); PG8_MMA(0, 1, At, B1); PG8_BAR; PG8_SCHED;
            PG8_LDA(At, 1, 1); PG8_STAGE(PG8_SB(1, 0), b3, voffB); PG8_STAGE(PG8_SB(1, 1), b3 + hstep, voffB); PG8_STAGE(PG8_SA(1, 0), a3, voffA);
            PG8_WAIT_V(8); PG8_WAIT_L(0); PG8_BAR; PG8_MMA(1, 0, At, B0); PG8_MMA(1, 1, At, B1); PG8_BAR; PG8_SCHED;
            } else {
            PG8_LDB(B0, 0, 0); PG8_SCHED; PG8_LDA(At, 0, 0); PG8_STAGE(PG8_SA(1, 1), a1 + hstep, voffA);
            PG8_WAIT_L(8); PG8_BAR; PG8_WAIT_L(0); PG8_MMA(0, 0, At, B0); PG8_BAR; PG8_SCHED;
            PG8_LDB(B1, 0, 1); PG8_STAGE(PG8_SB(0, 0), b2, voffB);
            PG8_BAR; PG8_WAIT_L(0); PG8_MMA(0, 1, At, B1); PG8_BAR;
            PG8_LDA(At, 0, 1); PG8_STAGE(PG8_SA(0, 0), a2, voffA);
            PG8_BAR; PG8_WAIT_L(0); PG8_MMA(1, 0, At, B0); PG8_BAR; PG8_SCHED;
            PG8_STAGE(PG8_SB(0, 1), b2 + hstep, voffB);
            PG8_WAIT_V(6); PG8_BAR; PG8_MMA(1, 1, At, B1); PG8_BAR;
            PG8_LDB(B0, 1, 0); PG8_SCHED; PG8_LDA(At, 1, 0); PG8_STAGE(PG8_SA(0, 1), a2 + hstep, voffA);
            PG8_WAIT_L(8); PG8_BAR; PG8_WAIT_L(0); PG8_MMA(0, 0, At, B0); PG8_BAR; PG8_SCHED;
            PG8_LDB(B1, 1, 1); PG8_STAGE(PG8_SB(1, 0), b3, voffB);
            PG8_BAR; PG8_WAIT_L(0); PG8_MMA(0, 1, At, B1); PG8_BAR;
            PG8_LDA(At, 1, 1); PG8_STAGE(PG8_SA(1, 0), a3, voffA);
            PG8_BAR; PG8_WAIT_L(0); PG8_MMA(1, 0, At, B0); PG8_BAR; PG8_SCHED;
            PG8_STAGE(PG8_SB(1, 1), b3 + hstep, voffB);
            PG8_WAIT_V(6); PG8_BAR; PG8_MMA(1, 1, At, B1); PG8_BAR;
            }
        }
        if constexpr (ALIGN_EPI) { if (wr == 0) PG8_BAR; }
        if constexpr (!Epi::AFTER_DRAIN) { E(acc, cur, wr, wc, fr, fq); S.done(cur); }
        if (!has_next) break;
#pragma unroll
        for (int a = 0; a < 2; ++a)
#pragma unroll
            for (int b = 0; b < 2; ++b)
#pragma unroll
                for (int m = 0; m < 4; ++m)
#pragma unroll
                    for (int n = 0; n < 2; ++n) acc[a][b][m][n] = (f32x4){0.f, 0.f, 0.f, 0.f};
        cur = nxt; cA = nA; cB = nB; ++ui;
        if constexpr (ALIGN_EPI) { if (wr == 1) PG8_BAR; }
    }
    PG8_WAIT_V(0);
    if constexpr (!ALIGN_EPI) { if (wr == 0) PG8_BAR; }
    PG8_BAR;
    if constexpr (Epi::AFTER_DRAIN) { E.fused(acc, cur, wr, wc, fr, fq, lds, wid, lane); S.done(cur); }
#undef PG8_SA
#undef PG8_SB
#undef PG8_STAGE
#undef PG8_LDA
#undef PG8_LDB
#undef PG8_MMA
#undef PG8_WAIT_V
#undef PG8_WAIT_L
#undef PG8_BAR
#undef PG8_SCHED
}
}
#ifndef DIS
#define DIS 0
#endif
#ifndef NAIVE_ATTN
#define NAIVE_ATTN 0
#endif
#ifndef MK_PER_PHASE
#define MK_PER_PHASE 0
#endif
constexpr int NB = 2, SEQ = 4096, MT = NB * SEQ, DM = 2048, NH = 7680, GW = 512, PLE = 256, DEPTH = 2;
constexpr int C_AB = 0, C_AC = 512, C_AX = 1024, C_BQ = 1536, C_BF = 2048, C_BI = 2560, C_CQ = 3072, C_CK = 3584, C_CV = 4096, C_DU = 4608, C_DV = 5120, C_GA = 5632, C_GB = 6144, C_GC = 6656, C_GD = 7168;
constexpr int Y_A = 0, Y_B = 512, Y_C = 1024, Y_D = 1536;
constexpr float ALPHA = 1.4142135623730951f;
constexpr float LN_EPS = 1e-5f, RMS_EPS = 1e-6f;
constexpr size_t MiB = 1u << 20;
constexpr size_t WS_WIN = 2 * MiB, WS_WOUT = 62 * MiB, WS_WPG = 78 * MiB, WS_WPE = 94 * MiB, WS_XB = 96 * MiB, WS_PB = 128 * MiB, WS_PE = 136 * MiB, WS_H = 168 * MiB,
                 WS_VT = 288 * MiB, WS_YCAT = 296 * MiB, WS_Z = 328 * MiB, WS_ATMP = 328 * MiB  , WS_XLNB = 392 * MiB, WS_HS = 424 * MiB  , WS_SB = 456 * MiB  , WS_DD = 472 * MiB  , WS_END = 473 * MiB;
constexpr int LDS_BYTES = 147456;
typedef unsigned short bf16;
typedef unsigned v4u __attribute__((ext_vector_type(4)));
typedef unsigned v2u __attribute__((ext_vector_type(2)));
typedef float f32x4 __attribute__((ext_vector_type(4)));
#define LAS __attribute__((address_space(3)))
#define GAS __attribute__((address_space(1)))
#define LDS_WAIT() asm volatile("s_waitcnt lgkmcnt(0)" ::: "memory")
__device__ __forceinline__ unsigned pk2(float lo, float hi) { unsigned r; asm("v_cvt_pk_bf16_f32 %0, %1, %2" : "=v"(r) : "v"(lo), "v"(hi)); return r; }
__device__ __forceinline__ unsigned f2bf(float f) { return pk2(f, 0.f) & 0xffffu; }
__device__ __forceinline__ float bfe(const v4u& v, int e) { const unsigned w = v[e >> 1]; return (e & 1) ? __uint_as_float(w & 0xffff0000u) : __uint_as_float(w << 16); }
__device__ __forceinline__ float bf1(bf16 b) { return __uint_as_float(((unsigned)b) << 16); }
__device__ __forceinline__ float wave_sum(float v) {
#pragma unroll
    for (int o = 1; o < 64; o <<= 1) v += __shfl_xor(v, o);
    return v;
}
__device__ __forceinline__ void p0_transpose_item(const float* W, int K, int N, bf16* WT, float* scr, int item, int lane, const float* scale, const float* cb, float* c1, float* c2) {
    const int nblk = N / 64, kb = item / nblk, nb = item % nblk, k0 = 64 * kb, n0 = 64 * nb;
    const int lr = lane >> 4, lc = (lane & 15) * 4;
    f32x4 v[16];
#pragma unroll
    for (int i = 0; i < 16; ++i) v[i] = *(const f32x4*)(W + (size_t)(k0 + 4 * i + lr) * N + n0 + lc);
#pragma unroll
    for (int i = 0; i < 16; ++i) { const int kk = 4 * i + lr; f32x4 w = v[i]; if (scale) w = w * scale[k0 + kk]; float* d = scr + kk * 65 + lc; d[0] = w[0]; d[1] = w[1]; d[2] = w[2]; d[3] = w[3]; }
    LDS_WAIT(); asm volatile("" ::: "memory");
    const int c = lane & 7;
#pragma unroll
    for (int j = 0; j < 8; ++j) { const int n = (lane >> 3) + 8 * j; const float* sp = scr + (8 * c) * 65 + n;
        v4u o; o.x = pk2(sp[0 * 65], sp[1 * 65]); o.y = pk2(sp[2 * 65], sp[3 * 65]); o.z = pk2(sp[4 * 65], sp[5 * 65]); o.w = pk2(sp[6 * 65], sp[7 * 65]);
        *(v4u*)(WT + (size_t)(n0 + n) * K + k0 + 8 * c) = o; }
    if (c1) { float a1 = 0.f, a2 = 0.f;
        for (int kk = 0; kk < 64; ++kk) { a1 += __uint_as_float(f2bf(scr[kk * 65 + lane]) << 16); a2 += cb[k0 + kk] * W[(size_t)(k0 + kk) * N + n0 + lane]; }
        atomicAdd(c1 + n0 + lane, a1); atomicAdd(c2 + n0 + lane, a2); }
    LDS_WAIT(); asm volatile("" ::: "memory");
}

#define RLX_AGENT __ATOMIC_RELAXED, __HIP_MEMORY_SCOPE_AGENT
#define XB_TMO      128
#define XB_XCNT(j)  (256  + 64 * (j))
#define XB_XSUB(j)  (1280 + 64 * (j))
#define XB_XGEN(j)  (2304 + 64 * (j))
#define XB_TOP      3328
#define XB_TOPGEN   3392
#define XCD_BAR_WORDS 3456
#define XB_SPIN_CAP (1u << 18)

__device__ __forceinline__ unsigned xb_ld(unsigned* p)              { return __hip_atomic_load(p, __ATOMIC_RELAXED, __HIP_MEMORY_SCOPE_AGENT); }
__device__ __forceinline__ unsigned xb_add(unsigned* p, unsigned v) { return __hip_atomic_fetch_add(p, v, __ATOMIC_RELAXED, __HIP_MEMORY_SCOPE_AGENT); }
__device__ __forceinline__ unsigned xb_xcc_id() { return (unsigned)__builtin_amdgcn_s_getreg((3 << 11) | 20) & 0xFu; }
#define XB_SPIN(cond, bar) do { unsigned _sp = 0; while (cond) { __builtin_amdgcn_s_sleep(1); \
    if ((++_sp & 255u) == 0u) { if (xb_ld(&(bar)[XB_TMO])) break; if (_sp > XB_SPIN_CAP) { atomicAdd(&(bar)[XB_TMO], 1u); break; } } } } while (0)

struct XcdBarrier {
    unsigned* bar; unsigned x;
    volatile LAS unsigned* st;
};

__device__ __forceinline__ XcdBarrier xcd_barrier_post(unsigned* bar, volatile LAS unsigned* st) {
    XcdBarrier b; b.bar = bar; b.x = xb_xcc_id(); b.st = st;
    if (threadIdx.x == 0) (void)xb_add(&bar[XB_XCNT(b.x)], 1u);
    return b;
}
__device__ __forceinline__ void xcd_barrier_complete(unsigned* bar, unsigned x, unsigned& nloc, unsigned& nx) {
    const unsigned G = gridDim.x * gridDim.y * gridDim.z;
    unsigned sum, cnt, mine, sp = 0u;
    for (;;) {
        sum = 0u; cnt = 0u; mine = 0u;
#pragma unroll
        for (unsigned j = 0; j < 16; ++j) { const unsigned c = xb_ld(&bar[XB_XCNT(j)]); sum += c; cnt += (c > 0u) ? 1u : 0u; mine = (j == x) ? c : mine; }
        if (sum == G) break;
        __builtin_amdgcn_s_sleep(1);
        if ((++sp & 255u) == 0u) { if (xb_ld(&bar[XB_TMO])) break; if (sp > XB_SPIN_CAP) { atomicAdd(&bar[XB_TMO], 1u); break; } }
    }
    nloc = mine > 0u ? mine : 1u; nx = cnt > 0u ? cnt : 1u;
}

__device__ __forceinline__ void xcd_barrier(const XcdBarrier& b) {
    asm volatile("s_waitcnt vmcnt(0)" ::: "memory");
    __syncthreads();
    if (threadIdx.x == 0) {
        unsigned* bar = b.bar;
        __builtin_amdgcn_s_waitcnt(0);
        unsigned nloc = b.st[0], nx = b.st[1];
        if (nloc == 0u) { xcd_barrier_complete(bar, b.x, nloc, nx); b.st[0] = nloc; b.st[1] = nx; }
        const unsigned old = xb_add(&bar[XB_XSUB(b.x)], 1u);
        const unsigned gen = old / nloc;
        if (old + 1u == (gen + 1u) * nloc) {
            __builtin_amdgcn_fence(__ATOMIC_RELEASE, "agent");
            asm volatile("s_waitcnt vmcnt(0)" ::: "memory");
            const unsigned og = xb_add(&bar[XB_TOP], 1u);
            const unsigned tg = og / nx;
            if (og + 1u == (tg + 1u) * nx) xb_add(&bar[XB_TOPGEN], 1u);
            else XB_SPIN(xb_ld(&bar[XB_TOPGEN]) == tg, bar);
            __builtin_amdgcn_fence(__ATOMIC_ACQUIRE, "agent");
            xb_add(&bar[XB_XGEN(b.x)], 1u);
            asm volatile("s_waitcnt vmcnt(0)" ::: "memory");
        } else {
            XB_SPIN(xb_ld(&bar[XB_XGEN(b.x)]) == gen, bar);
            __builtin_amdgcn_fence(__ATOMIC_ACQUIRE, "agent");
            asm volatile("s_waitcnt vmcnt(0)" ::: "memory");
        }
    }
    __syncthreads();
}

__device__ __forceinline__ void xcd_barrier_arrive(const XcdBarrier& b) {
    asm volatile("s_waitcnt vmcnt(0)" ::: "memory");
    __syncthreads();
    if (threadIdx.x == 0) {
        unsigned* bar = b.bar;
        __builtin_amdgcn_s_waitcnt(0);
        unsigned nloc = b.st[0], nx = b.st[1];
        if (nloc == 0u) { xcd_barrier_complete(bar, b.x, nloc, nx); b.st[0] = nloc; b.st[1] = nx; }
        const unsigned old = xb_add(&bar[XB_XSUB(b.x)], 1u);
        const unsigned gen = old / nloc;
        unsigned role = 0u, tg = 0u;
        if (old + 1u == (gen + 1u) * nloc) {
            __builtin_amdgcn_fence(__ATOMIC_RELEASE, "agent");
            asm volatile("s_waitcnt vmcnt(0)" ::: "memory");
            const unsigned og = xb_add(&bar[XB_TOP], 1u);
            tg = og / nx; role = 1u;
            if (og + 1u == (tg + 1u) * nx) { xb_add(&bar[XB_TOPGEN], 1u); role = 2u; }
        }
        b.st[2] = role; b.st[3] = gen; b.st[4] = tg;
    }
}
__device__ __forceinline__ void xcd_barrier_wait(const XcdBarrier& b) {
    if (threadIdx.x == 0) {
        unsigned* bar = b.bar; const unsigned role = b.st[2], gen = b.st[3], tg = b.st[4];
        if (role) {
            if (role == 1u) XB_SPIN(xb_ld(&bar[XB_TOPGEN]) == tg, bar);
            __builtin_amdgcn_fence(__ATOMIC_ACQUIRE, "agent");
            xb_add(&bar[XB_XGEN(b.x)], 1u);
            asm volatile("s_waitcnt vmcnt(0)" ::: "memory");
        } else {
            XB_SPIN(xb_ld(&bar[XB_XGEN(b.x)]) == gen, bar);
            __builtin_amdgcn_fence(__ATOMIC_ACQUIRE, "agent");
            asm volatile("s_waitcnt vmcnt(0)" ::: "memory");
        }
    }
    __syncthreads();
}
__device__ __forceinline__ int tid_opaque() { int t = threadIdx.x; asm volatile("" : "+v"(t)); return t; }
struct Args { const float* in[17]; float* out; unsigned char* ws; int ph_lo, ph_hi; };

__device__ __forceinline__ void mix_conv(const bf16* h, const float* cw, bf16* ycat, int gtid, int gstride) {
    for (int it = gtid; it < MT * 64; it += gstride) {
        const int m = it >> 6, c = (it & 63) * 8, t = m & (SEQ - 1);
        const bf16* hr = h + (size_t)m * NH;
        const v4u bb = *(const v4u*)(hr + C_AB + c), ga = *(const v4u*)(hr + C_GA + c);
        float acc[8];
#pragma unroll
        for (int e = 0; e < 8; ++e) acc[e] = 0.f;
#pragma unroll
        for (int j = 0; j < 3; ++j) { const int dt = 2 - j;
            if (t - dt >= 0) { const bf16* hp = hr - (size_t)dt * NH; const v4u cc = *(const v4u*)(hp + C_AC + c), xx = *(const v4u*)(hp + C_AX + c);
#pragma unroll
                for (int e = 0; e < 8; ++e) acc[e] += cw[j * GW + c + e] * (bfe(cc, e) * bfe(xx, e)); } }
        v4u o;
#pragma unroll
        for (int e = 0; e < 4; ++e) o[e] = pk2(bfe(bb, 2 * e) * acc[2 * e] * bfe(ga, 2 * e), bfe(bb, 2 * e + 1) * acc[2 * e + 1] * bfe(ga, 2 * e + 1));
        *(v4u*)(ycat + (size_t)m * DM + Y_A + c) = o;
    }
}
__device__ __forceinline__ void mix_sgu(const bf16* h, const float* lng, const float* lnb, const float* sgw, const float* sgb, bf16* ycat, char* lds, int wg, int nwg) {
    typedef _Float16 sbf16x8 __attribute__((ext_vector_type(8)));
    const int tid = tid_opaque(), lane = tid & 63, wid = __builtin_amdgcn_readfirstlane(tid >> 6), li = lane & 15, g = lane >> 4;
    for (int item = wg; item < NB * 32 * 4; item += nwg) {
        const int grp = item & 3, n = (item >> 2) & 31, b = item >> 7;
        const size_t m0 = (size_t)b * SEQ + n * 128;
#pragma unroll
        for (int i = 0; i < 8; ++i) { const int idx = tid + 512 * i, t = idx >> 5, s4 = (idx & 31) * 4; const f32x4 w = *(const f32x4*)(sgw + (size_t)grp * 16384 + t * 128 + s4);
            typedef _Float16 h4 __attribute__((ext_vector_type(4))); h4 o; o[0] = (_Float16)(s4 <= t ? w[0] : 0.f); o[1] = (_Float16)(s4 + 1 <= t ? w[1] : 0.f); o[2] = (_Float16)(s4 + 2 <= t ? w[2] : 0.f); o[3] = (_Float16)(s4 + 3 <= t ? w[3] : 0.f); *(h4*)(lds + t * 288 + s4 * 2) = o; }
        { const int row = tid >> 2, q = tid & 3; const bf16* vr = h + (m0 + row) * NH + C_DV;
          float s1 = 0.f, s2 = 0.f;
#pragma unroll
          for (int j = 0; j < 16; ++j) { const v4u vv = *(const v4u*)(vr + (4 * j + q) * 8);
#pragma unroll
              for (int e = 0; e < 8; ++e) { const float x = bfe(vv, e); s1 += x; s2 += x * x; } }
          s1 += __shfl_xor(s1, 1); s1 += __shfl_xor(s1, 2); s2 += __shfl_xor(s2, 1); s2 += __shfl_xor(s2, 2);
          const float mu = s1 * (1.f / 512.f), rstd = rsqrtf(fmaxf(s2 * (1.f / 512.f) - mu * mu, 0.f) + LN_EPS);
#pragma unroll
          for (int j = 0; j < 4; ++j) { const int c0 = 32 * q + 8 * j; const v4u vv = *(const v4u*)(vr + 128 * grp + c0);
#pragma unroll
              for (int e = 0; e < 8; ++e) { const float y = (bfe(vv, e) - mu) * rstd * lng[128 * grp + c0 + e] + lnb[128 * grp + c0 + e]; *(_Float16*)(lds + 36864 + (c0 + e) * 288 + row * 2) = (_Float16)y; } } }
        __syncthreads();
        pg8::f32x4 acc[8];
#pragma unroll
        for (int nb = 0; nb < 8; ++nb) acc[nb] = (pg8::f32x4){0.f, 0.f, 0.f, 0.f};
        const int nks = (16 * wid + 15) / 32 + 1;
        for (int ks = 0; ks < nks; ++ks) { const sbf16x8 wf = *(const sbf16x8*)(lds + (16 * wid + li) * 288 + ks * 64 + g * 16);
#pragma unroll
            for (int nb = 0; nb < 8; ++nb) { const sbf16x8 vf = *(const sbf16x8*)(lds + 36864 + (16 * nb + li) * 288 + ks * 64 + g * 16); acc[nb] = __builtin_amdgcn_mfma_f32_16x16x32_f16(vf, wf, acc[nb], 0, 0, 0); } }
        { const int t = 16 * wid + li; const float bias = sgb[grp * 128 + t];
          const bf16* hr = h + (m0 + t) * NH + 128 * grp + 4 * g; bf16* yr = ycat + (m0 + t) * DM + Y_D + 128 * grp + 4 * g;
#pragma unroll
          for (int nb = 0; nb < 8; ++nb) { const v2u uu = *(const v2u*)(hr + C_DU + 16 * nb), gd = *(const v2u*)(hr + C_GD + 16 * nb);
              v2u o; o.x = pk2(__uint_as_float(uu.x << 16) * (acc[nb][0] + bias) * __uint_as_float(gd.x << 16), __uint_as_float(uu.x & 0xffff0000u) * (acc[nb][1] + bias) * __uint_as_float(gd.x & 0xffff0000u));
              o.y = pk2(__uint_as_float(uu.y << 16) * (acc[nb][2] + bias) * __uint_as_float(gd.y << 16), __uint_as_float(uu.y & 0xffff0000u) * (acc[nb][3] + bias) * __uint_as_float(gd.y & 0xffff0000u));
              *(v2u*)(yr + 16 * nb) = o; } }
        __syncthreads();
    }
}
typedef short hbf16x8 __attribute__((ext_vector_type(8)));
__device__ __forceinline__ float hg_lb(const float* lbraw, int layer, int ch) { if (layer == 0) return 0.f; const float e0 = __expf(lbraw[ch]), e1 = __expf(lbraw[GW + ch]); return e1 / (e0 + e1); }
__device__ __forceinline__ void hg_gate(float fzraw, float lb, float& gl, float& kk) { const float fz = fminf(fmaxf(fzraw, -80.f), 80.f), ex = __expf(-fz), sg = __builtin_amdgcn_rcpf(1.f + ex);
    gl = __builtin_amdgcn_logf(fmaxf(lb + (1.f - lb) * sg, 1e-30f)) * 0.6931471805599453f;     kk = (1.f - lb) * (ex * sg); }
__device__ __forceinline__ void hgrn_pass1(const bf16* h, const float* lbraw, int layer, float* US, float* DD, char* lds, int wg, int G) {
    const int tid = tid_opaque(), lane = tid & 63, wid = __builtin_amdgcn_readfirstlane(tid >> 6), li = lane & 15, g = lane >> 4, half = wid >> 2, hw = wid & 3;
    char* L = lds + half * 43008; float* TOT = (float*)(L + 40960);
    const int ht = tid & 255, k = ht & 127, seg2 = ht >> 7;
    for (int pair = wg; pair < 256; pair += G) {
        const int item = 2 * pair + half, c = item & 63, bh = item >> 6, hh = bh & 3, b = bh >> 2; const size_t m0 = (size_t)b * SEQ + c * 64 + 32 * seg2;
        const bf16* hp = h + m0 * NH + hh * 128 + k;
        bf16 fzv[32], ivv[32];
#pragma unroll
        for (int i = 0; i < 32; ++i) { fzv[i] = hp[(size_t)i * NH + C_BF]; ivv[i] = hp[(size_t)i * NH + C_BI]; }
        const float lb = hg_lb(lbraw, layer, hh * 128 + k);
        float bl[32], kk[32], run = 0.f;
#pragma unroll
        for (int i = 0; i < 32; ++i) { float gl; hg_gate(bf1(fzv[i]), lb, gl, kk[i]); run += gl; bl[i] = run; }
        TOT[seg2 * 128 + k] = run;
        { v4u w[4];
#pragma unroll
          for (int i = 0; i < 32; i += 2) w[i >> 3][(i >> 1) & 3] = (unsigned)ivv[i] | ((unsigned)ivv[i + 1] << 16);
#pragma unroll
          for (int j = 0; j < 4; ++j) *(v4u*)(L + 20480 + k * 160 + seg2 * 64 + j * 16) = w[j]; }
        __syncthreads();
        const float tot0 = TOT[k], tot1 = TOT[128 + k], b63 = tot0 + tot1, base = b63 - (seg2 ? tot0 : 0.f);
        { v4u w[4];
#pragma unroll
          for (int i = 0; i < 32; i += 2) w[i >> 3][(i >> 1) & 3] = pk2(kk[i] * __expf(base - bl[i]), kk[i + 1] * __expf(base - bl[i + 1]));
#pragma unroll
          for (int j = 0; j < 4; ++j) *(v4u*)(L + k * 160 + seg2 * 64 + j * 16) = w[j]; }
        if (seg2 == 0) DD[item * 128 + k] = __expf(b63);
        __syncthreads();
#pragma unroll
        for (int mbi = 0; mbi < 2; ++mbi) { const int mb = 2 * hw + mbi;
            pg8::f32x4 acc[8];
#pragma unroll
            for (int nb = 0; nb < 8; ++nb) acc[nb] = (pg8::f32x4){0.f, 0.f, 0.f, 0.f};
#pragma unroll
            for (int ks = 0; ks < 2; ++ks) { const hbf16x8 af = *(const hbf16x8*)(L + (16 * mb + li) * 160 + ks * 64 + g * 16);
#pragma unroll
                for (int nb = 0; nb < 8; ++nb) { const hbf16x8 bb = *(const hbf16x8*)(L + 20480 + (16 * nb + li) * 160 + ks * 64 + g * 16); acc[nb] = __builtin_amdgcn_mfma_f32_16x16x32_bf16(af, bb, acc[nb], 0, 0, 0); } }
#pragma unroll
            for (int nb = 0; nb < 8; ++nb) *(pg8::f32x4*)(US + (size_t)item * 16384 + (16 * nb + li) * 128 + 16 * mb + 4 * g) = acc[nb]; }
        __syncthreads();
    }
}
__device__ __forceinline__ void hgrn_scan(const float* US, const float* DD, bf16* SB, int gtid, int gstride) {
    for (int e = gtid; e < 8 * 16384; e += gstride) { const int chain = e >> 14, idx = e & 16383, k = idx & 127; float run = 0.f;
        for (int c0 = 0; c0 < 64; c0 += 16) { float u[16], d[16];
#pragma unroll
            for (int j = 0; j < 16; ++j) { u[j] = US[(size_t)(chain * 64 + c0 + j) * 16384 + idx]; d[j] = DD[(chain * 64 + c0 + j) * 128 + k]; }
#pragma unroll
            for (int j = 0; j < 16; ++j) { SB[(size_t)(chain * 64 + c0 + j) * 16384 + idx] = (bf16)f2bf(run); run = d[j] * run + u[j]; } } }
}
constexpr int H3_QH = 0, H3_QT = 18432, H3_KT = 36864, H3_IVT = 82944, H3_AM = 103424, H3_TOT = 113664, H3_SS = 115712;
__device__ __forceinline__ void hgrn_pass3(const bf16* h, const float* lbraw, int layer, const bf16* SB, const float* ng, bf16* ycat, char* lds, int wg, int G) {
    const int tid = tid_opaque(), lane = tid & 63, wid = __builtin_amdgcn_readfirstlane(tid >> 6), li = lane & 15, g = lane >> 4;
    const int k = tid & 127, seg = tid >> 7, tb = wid & 3, vh = wid >> 2;
    float* TOT = (float*)(lds + H3_TOT); float* SS = (float*)(lds + H3_SS);
    for (int item = wg; item < 512; item += G) {
        const int c = item & 63, bh = item >> 6, hh = bh & 3, b = bh >> 2; const size_t m0 = (size_t)b * SEQ + c * 64;
        const bf16* hp = h + (m0 + 16 * seg) * NH + hh * 128 + k;
        bf16 fzv[16], qv[16], ivv[16];
#pragma unroll
        for (int i = 0; i < 16; ++i) { fzv[i] = hp[(size_t)i * NH + C_BF]; qv[i] = hp[(size_t)i * NH + C_BQ]; ivv[i] = hp[(size_t)i * NH + C_BI]; }
        hbf16x8 sbf[4][4];
#pragma unroll
        for (int ks = 0; ks < 4; ++ks)
#pragma unroll
            for (int nb = 0; nb < 4; ++nb) sbf[ks][nb] = *(const hbf16x8*)(SB + (size_t)item * 16384 + (16 * (vh * 4 + nb) + li) * 128 + ks * 32 + 8 * g);
        v2u gate[4];
#pragma unroll
        for (int nb = 0; nb < 4; ++nb) gate[nb] = *(const v2u*)(h + (m0 + 16 * tb + li) * NH + C_GB + hh * 128 + 16 * (vh * 4 + nb) + 4 * g);
        const float lb = hg_lb(lbraw, layer, hh * 128 + k);
        float bl[16], kk[16], run = 0.f;
#pragma unroll
        for (int i = 0; i < 16; ++i) { float gl; hg_gate(bf1(fzv[i]), lb, gl, kk[i]); run += gl; bl[i] = run; }
        TOT[seg * 128 + k] = run;
        { v4u w[2];
#pragma unroll
          for (int i = 0; i < 16; i += 2) w[i >> 3][(i >> 1) & 3] = (unsigned)ivv[i] | ((unsigned)ivv[i + 1] << 16);
          *(v4u*)(lds + H3_IVT + k * 160 + seg * 32) = w[0]; *(v4u*)(lds + H3_IVT + k * 160 + seg * 32 + 16) = w[1]; }
        __syncthreads();
        float pre[4]; pre[0] = 0.f; pre[1] = TOT[k]; pre[2] = pre[1] + TOT[128 + k]; pre[3] = pre[2] + TOT[256 + k];
        const float mypre = (seg == 0) ? 0.f : (seg == 1) ? pre[1] : (seg == 2) ? pre[2] : pre[3];
#pragma unroll
        for (int i = 0; i < 16; ++i) { const int t = 16 * seg + i; const float qraw = bf1(qv[i]);
            *(bf16*)(lds + H3_QT + t * 288 + k * 2) = (bf16)f2bf(qraw * __expf(bl[i])); *(bf16*)(lds + H3_QH + t * 288 + k * 2) = (bf16)f2bf(qraw * __expf(mypre + bl[i]));
#pragma unroll
            for (int I = 0; I < 4; ++I) if (I >= seg) { const int rowoff = (I == 0) ? 0 : (I == 1) ? 16 : (I == 2) ? 48 : 96;
                *(bf16*)(lds + H3_KT + (rowoff + t) * 288 + k * 2) = (bf16)f2bf(kk[i] * __expf(fminf(pre[I] - (mypre + bl[i]), 80.f))); } }
        __syncthreads();
        for (int rep = 0; rep < 2; ++rep) {
            int I = -1, J = 0; bool zero = false;
            if (rep == 0) { if (wid == 0) { I = 0; J = 0; } else if (wid == 1) { I = 1; J = 0; } else if (wid == 2) { I = 1; J = 1; } else if (wid == 3) { I = 2; J = 0; } else if (wid == 4) { I = 2; J = 1; } else if (wid == 5) { I = 2; J = 2; }
                            else if (wid == 6) { I = 0; J = 1; zero = true; } else { I = 2; J = 3; zero = true; } }
            else if (wid < 4) { I = 3; J = wid; }
            if (I < 0) continue;
            pg8::f32x4 acc = (pg8::f32x4){0.f, 0.f, 0.f, 0.f};
            if (!zero) { const int rowoff = (I == 0) ? 0 : (I == 1) ? 16 : (I == 2) ? 48 : 96;
#pragma unroll
                for (int ks = 0; ks < 4; ++ks) { const hbf16x8 af = *(const hbf16x8*)(lds + H3_QT + (16 * I + li) * 288 + ks * 64 + g * 16), bb = *(const hbf16x8*)(lds + H3_KT + (rowoff + 16 * J + li) * 288 + ks * 64 + g * 16);
                    acc = __builtin_amdgcn_mfma_f32_16x16x32_bf16(af, bb, acc, 0, 0, 0); } }
#pragma unroll
            for (int r = 0; r < 4; ++r) { const float v = (I == J && li > 4 * g + r) ? 0.f : acc[r]; *(bf16*)(lds + H3_AM + (16 * I + 4 * g + r) * 160 + (16 * J + li) * 2) = (bf16)f2bf(v); }
        }
        __syncthreads();
        pg8::f32x4 oacc[4];
#pragma unroll
        for (int nb = 0; nb < 4; ++nb) oacc[nb] = (pg8::f32x4){0.f, 0.f, 0.f, 0.f};
        for (int ks = 0; ks < ((tb < 2) ? 1 : 2); ++ks) { const hbf16x8 af = *(const hbf16x8*)(lds + H3_AM + (16 * tb + li) * 160 + ks * 64 + g * 16);
#pragma unroll
            for (int nb = 0; nb < 4; ++nb) { const hbf16x8 bb = *(const hbf16x8*)(lds + H3_IVT + (16 * (vh * 4 + nb) + li) * 160 + ks * 64 + g * 16); oacc[nb] = __builtin_amdgcn_mfma_f32_16x16x32_bf16(bb, af, oacc[nb], 0, 0, 0); } }
#pragma unroll
        for (int ks = 0; ks < 4; ++ks) { const hbf16x8 af = *(const hbf16x8*)(lds + H3_QH + (16 * tb + li) * 288 + ks * 64 + g * 16);
#pragma unroll
            for (int nb = 0; nb < 4; ++nb) oacc[nb] = __builtin_amdgcn_mfma_f32_16x16x32_bf16(sbf[ks][nb], af, oacc[nb], 0, 0, 0); }
        { float q = 0.f;
#pragma unroll
          for (int nb = 0; nb < 4; ++nb)
#pragma unroll
              for (int r = 0; r < 4; ++r) q += oacc[nb][r] * oacc[nb][r];
          q += __shfl_xor(q, 16); q += __shfl_xor(q, 32);
          if (g == 0) SS[(16 * tb + li) * 2 + vh] = q; }
        __syncthreads();
        { const int t = 16 * tb + li; const float rsn = rsqrtf((SS[t * 2] + SS[t * 2 + 1]) * (1.f / 128.f) + RMS_EPS);
          bf16* yp = ycat + (m0 + t) * DM + Y_B + hh * 128 + 4 * g; const float* ngp = ng + hh * 128 + 4 * g;
#pragma unroll
          for (int nb = 0; nb < 4; ++nb) { const int v0 = 16 * (vh * 4 + nb); const pg8::f32x4 nv = *(const pg8::f32x4*)(ngp + v0); const v2u gt = gate[nb];
              v2u w; w.x = pk2(oacc[nb][0] * rsn * nv[0] * __uint_as_float(gt.x << 16), oacc[nb][1] * rsn * nv[1] * __uint_as_float(gt.x & 0xffff0000u));
              w.y = pk2(oacc[nb][2] * rsn * nv[2] * __uint_as_float(gt.y << 16), oacc[nb][3] * rsn * nv[3] * __uint_as_float(gt.y & 0xffff0000u));
              *(v2u*)(yp + v0) = w; } }
        __syncthreads();
    }
}
__device__ __forceinline__ void mix_attn_naive(const bf16* h, float* atmp, int gw, int ngw, int lane) {
    for (int item = gw; item < NB * 4 * 64 * 8; item += ngw) {
        const int sl = item & 3, st = (item >> 2) & 1, bh = (item >> 3) & 7, qb = 63 - (item >> 6);
        const int b = bh >> 2, hh = bh & 3, q0 = qb * 64, row = q0 + lane;
        float q[64];
        { const bf16* qp = h + (size_t)(b * SEQ + row) * NH + C_CQ + hh * 128 + st * 64;
#pragma unroll
          for (int j = 0; j < 8; ++j) { const v4u w = *(const v4u*)(qp + 8 * j);
#pragma unroll
              for (int e = 0; e < 8; ++e) q[8 * j + e] = bfe(w, e) * 0.125f; } }
        float O[32], mx = -1e30f, l = 0.f;
#pragma unroll
        for (int j = 0; j < 32; ++j) O[j] = 0.f;
        for (int key = 0; key < q0 + 64; ++key) {
            const bf16* kp = h + (size_t)(b * SEQ + key) * NH + C_CK + hh * 128 + st * 64;
            float sc = 0.f;
#pragma unroll
            for (int j = 0; j < 8; ++j) { const v4u w = *(const v4u*)(kp + 8 * j);
#pragma unroll
                for (int e = 0; e < 8; ++e) sc += q[8 * j + e] * bfe(w, e); }
            if (key <= row) {
                const float mn = fmaxf(mx, sc), cf = __expf(mx - mn), pp = __expf(sc - mn);
                l = l * cf + pp; mx = mn;
                const bf16* vp = h + (size_t)(b * SEQ + key) * NH + C_CV + hh * 128 + sl * 32;
#pragma unroll
                for (int j = 0; j < 4; ++j) { const v4u w = *(const v4u*)(vp + 8 * j);
#pragma unroll
                    for (int e = 0; e < 8; ++e) O[8 * j + e] = O[8 * j + e] * cf + pp * bfe(w, e); }
            }
        }
        const float il = 1.f / l;
        float* op = atmp + ((size_t)st * MT + (b * SEQ + row)) * GW + hh * 128 + sl * 32;
#pragma unroll
        for (int j = 0; j < 8; ++j) *(f32x4*)(op + 4 * j) = (f32x4){O[4 * j] * il, O[4 * j + 1] * il, O[4 * j + 2] * il, O[4 * j + 3] * il};
    }
}
__device__ __forceinline__ float diff_lam(const float* dl  , int layer) {
    float s1 = 0.f, s2 = 0.f;
    for (int j = 0; j < 64; ++j) { s1 += dl[j] * dl[64 + j]; s2 += dl[128 + j] * dl[192 + j]; }
    const float lam_init = 0.8f - 0.6f * expf(-0.3f * (float)layer);
    return expf(s1) - expf(s2) + lam_init;
}
__device__ __forceinline__ float xmax16_32(float v) {
    auto a = __builtin_amdgcn_permlane16_swap(__float_as_uint(v), __float_as_uint(v), false, false); v = fmaxf(__uint_as_float(a[0]), __uint_as_float(a[1]));
    auto b = __builtin_amdgcn_permlane32_swap(__float_as_uint(v), __float_as_uint(v), false, false); return fmaxf(__uint_as_float(b[0]), __uint_as_float(b[1])); }
__device__ __forceinline__ float xsum16_32(float v) {
    auto a = __builtin_amdgcn_permlane16_swap(__float_as_uint(v), __float_as_uint(v), false, false); v = __uint_as_float(a[0]) + __uint_as_float(a[1]);
    auto b = __builtin_amdgcn_permlane32_swap(__float_as_uint(v), __float_as_uint(v), false, false); return __uint_as_float(b[0]) + __uint_as_float(b[1]); }
typedef short bf16x8_t __attribute__((ext_vector_type(8)));
template <bool DO_S, bool DO_PV, bool DIAG>
__device__ __forceinline__ void attn_step(const char* Ks, const char* Vs, const bf16x8_t (&qf)[2], bf16x8_t (&pf)[2], pg8::f32x4 (&oacc)[8], float& mrun, float& lsum, bool diag, int rs, int li, int g) {
    constexpr int KROW = 160; constexpr float SC = 0.125f * 1.4426950408889634f;
    const char* kp = Ks + li * KROW + g * 16; const char* vp = Vs + li * KROW + g * 16;
    pg8::f32x4 sacc[4];
    if (DO_S) {
        bf16x8_t kf[8];
#pragma unroll
        for (int i = 0; i < 8; ++i) kf[i] = *(const bf16x8_t*)(kp + (i >> 1) * 16 * KROW + (i & 1) * 64);
#pragma unroll
        for (int kb = 0; kb < 4; ++kb) { sacc[kb] = __builtin_amdgcn_mfma_f32_16x16x32_bf16(kf[2 * kb], qf[0], (pg8::f32x4){0.f, 0.f, 0.f, 0.f}, 0, 0, 0); sacc[kb] = __builtin_amdgcn_mfma_f32_16x16x32_bf16(kf[2 * kb + 1], qf[1], sacc[kb], 0, 0, 0); }
    }
    bf16x8_t vf[16];
    if (DO_PV) {
#pragma unroll
        for (int i = 0; i < 16; ++i) vf[i] = *(const bf16x8_t*)(vp + (i >> 1) * 16 * KROW + (i & 1) * 64);
    }
    __builtin_amdgcn_sched_barrier(0);
    const bf16x8_t p0 = pf[0], p1 = pf[1];
    if (DO_PV) {
#pragma unroll
        for (int i = 0; i < 16; ++i) oacc[i >> 1] = __builtin_amdgcn_mfma_f32_16x16x32_bf16(vf[i], (i & 1) ? p1 : p0, oacc[i >> 1], 0, 0, 0);
    }
    float alpha = 1.f; bool grow = false;
    if (DO_S) {
        float mx = -INFINITY;
#pragma unroll
        for (int kb = 0; kb < 4; ++kb)
#pragma unroll
            for (int r = 0; r < 4; ++r) { float sv = sacc[kb][r]; if (DIAG && (16 * kb + 4 * g + r) > (16 * rs + li)) sv = -INFINITY; sacc[kb][r] = sv; mx = fmaxf(mx, sv); }
        mx = xmax16_32(mx);
        grow = mx > mrun + 8.0f / SC; const float mnew = grow ? mx : mrun; alpha = __builtin_amdgcn_exp2f((mrun - mnew) * SC); mrun = mnew;
        const float nm = -mnew * SC; pg8::f32x4 psv = (pg8::f32x4){0.f, 0.f, 0.f, 0.f};
#pragma unroll
        for (int kb = 0; kb < 4; ++kb) { pg8::f32x4 tt = sacc[kb] * SC + nm;
            tt[0] = __builtin_amdgcn_exp2f(tt[0]); tt[1] = __builtin_amdgcn_exp2f(tt[1]); tt[2] = __builtin_amdgcn_exp2f(tt[2]); tt[3] = __builtin_amdgcn_exp2f(tt[3]); sacc[kb] = tt; psv += tt; }
        const float ps = (psv[0] + psv[1]) + (psv[2] + psv[3]);
        lsum = lsum * alpha + ps;
#pragma unroll
        for (int ks = 0; ks < 2; ++ks) { v4u w; w.x = pg8::cvt_pk_bf16(sacc[2 * ks][0], sacc[2 * ks][1]); w.y = pg8::cvt_pk_bf16(sacc[2 * ks][2], sacc[2 * ks][3]);
            w.z = pg8::cvt_pk_bf16(sacc[2 * ks + 1][0], sacc[2 * ks + 1][1]); w.w = pg8::cvt_pk_bf16(sacc[2 * ks + 1][2], sacc[2 * ks + 1][3]); pf[ks] = __builtin_bit_cast(bf16x8_t, w); }
    }
    if (DO_S && DO_PV) {
#pragma unroll
        for (int i = 0; i < 16; ++i) { __builtin_amdgcn_sched_group_barrier(0x008, 1, 0); __builtin_amdgcn_sched_group_barrier(0x002, 7, 0); }
    }
    __builtin_amdgcn_sched_barrier(0);
    if (DO_S) { if (__any(grow)) {
#pragma unroll
        for (int i = 0; i < 8; ++i) oacc[i] = oacc[i] * alpha; }
    }
}
__device__ __forceinline__ void mix_attn(const bf16* h, const bf16* VT, const float* dl, int layer, const float* ng, bf16* ycat, char* lds, int wg, int G) {
    const int tid = tid_opaque(), lane = tid & 63, wid = __builtin_amdgcn_readfirstlane(tid >> 6), rs = wid & 3, st = wid >> 2, li = lane & 15, g = lane >> 4;
    const float lam = diff_lam(dl, layer), lam_init = 0.8f - 0.6f * expf(-0.3f * (float)layer);
    constexpr int KROW = 160, TB = 40960, K2OFF = 10240, VOFF = 20480;
    for (int c = wg; c < 256; c += G) {
        const int bh = c & 7, j = c >> 3, b = bh >> 2, hh = bh & 3;
        const size_t mrow0 = (size_t)b * SEQ;
        for (int half = 0; half < 2; ++half) {
            const int qb = half ? j : 63 - j, q0 = qb * 64;
            bf16x8_t qf[2];
            { const GAS bf16* qp = (const GAS bf16*)h + (mrow0 + q0 + 16 * rs + li) * NH + C_CQ + hh * 128 + st * 64 + 8 * g;
              qf[0] = *(const GAS bf16x8_t*)qp; qf[1] = *(const GAS bf16x8_t*)(qp + 32); }
            const GAS bf16* gsrc[4]; int ldst[4];
#pragma unroll
            for (int i = 0; i < 2; ++i) { const int cidx = tid + 512 * i, row = cidx >> 4, ch = cidx & 15;
                gsrc[i] = (const GAS bf16*)h + (mrow0 + row) * NH + C_CK + hh * 128 + ch * 8; ldst[i] = (ch < 8 ? 0 : K2OFF) + row * KROW + (ch & 7) * 16; }
#pragma unroll
            for (int i = 2; i < 4; ++i) { const int c2 = tid + 512 * (i - 2), row = c2 >> 3, ch = c2 & 7, cc = ch & 3;
                gsrc[i] = (const GAS bf16*)VT + (size_t)(hh * 128 + row) * MT + mrow0 + ch * 8; ldst[i] = VOFF + row * KROW + ((ch >> 2) * 32 + (cc & 1) * 16 + (cc >> 1) * 4) * 2; }
            v4u stA[4];
#define ATT_LOAD(S, t) do { S[0] = *(const GAS v4u*)(gsrc[0] + (size_t)(t) * 64 * NH); S[1] = *(const GAS v4u*)(gsrc[1] + (size_t)(t) * 64 * NH); S[2] = *(const GAS v4u*)(gsrc[2] + (t) * 64); S[3] = *(const GAS v4u*)(gsrc[3] + (t) * 64); } while (0)
#define ATT_STORE(S, boff) do { _Pragma("unroll") for (int i_ = 0; i_ < 2; ++i_) *(v4u*)(lds + (boff) + ldst[i_]) = S[i_]; \
    _Pragma("unroll") for (int i_ = 2; i_ < 4; ++i_) { v2u lo_, hi_; lo_.x = S[i_].x; lo_.y = S[i_].y; hi_.x = S[i_].z; hi_.y = S[i_].w; *(v2u*)(lds + (boff) + ldst[i_]) = lo_; *(v2u*)(lds + (boff) + ldst[i_] + 16) = hi_; } } while (0)
            int b0 = 0, b1 = TB, b2 = 2 * TB;
            ATT_LOAD(stA, 0); ATT_STORE(stA, b0);
            if (qb >= 1) ATT_LOAD(stA, 1);
            __syncthreads();
            pg8::f32x4 oacc[8];
#pragma unroll
            for (int i = 0; i < 8; ++i) oacc[i] = (pg8::f32x4){0.f, 0.f, 0.f, 0.f};
            float mrun = -INFINITY, lsum = 0.f; bf16x8_t pf[2];
            if (qb == 0) attn_step<true, false, true>(lds + b0 + st * K2OFF, lds + b0 + VOFF, qf, pf, oacc, mrun, lsum, true, rs, li, g);
            else attn_step<true, false, false>(lds + b0 + st * K2OFF, lds + b0 + VOFF, qf, pf, oacc, mrun, lsum, false, rs, li, g);
            if (qb >= 1) ATT_STORE(stA, b1);
            __syncthreads();
            for (int t = 0; t < qb; ++t) {
                if (t + 2 <= qb) ATT_LOAD(stA, t + 2);
                if (t + 1 == qb) attn_step<true, true, true>(lds + b1 + st * K2OFF, lds + b0 + VOFF, qf, pf, oacc, mrun, lsum, true, rs, li, g);
                else attn_step<true, true, false>(lds + b1 + st * K2OFF, lds + b0 + VOFF, qf, pf, oacc, mrun, lsum, false, rs, li, g);
                if (t + 2 <= qb) ATT_STORE(stA, b2);
                __syncthreads();
                const int tmp = b0; b0 = b1; b1 = b2; b2 = tmp;
            }
            attn_step<false, true, false>(lds + b0 + st * K2OFF, lds + b0 + VOFF, qf, pf, oacc, mrun, lsum, false, rs, li, g);
#undef ATT_LOAD
#undef ATT_STORE
            float* X = (float*)(lds + b1);
            lsum += __shfl_xor(lsum, 16); lsum += __shfl_xor(lsum, 32);
            const float inv = 1.f / lsum;
            if (st == 1) {
#pragma unroll
                for (int blk = 0; blk < 8; ++blk)
#pragma unroll
                    for (int r = 0; r < 4; ++r) X[(rs * 32 + blk * 4 + r) * 64 + lane] = oacc[blk][r] * (inv * lam);
            }
            __syncthreads();
            if (st == 0) {
                float ss = 0.f;
#pragma unroll
                for (int blk = 0; blk < 8; ++blk)
#pragma unroll
                    for (int r = 0; r < 4; ++r) { const float o = oacc[blk][r] * inv - X[(rs * 32 + blk * 4 + r) * 64 + lane]; oacc[blk][r] = o; ss += o * o; }
                ss += __shfl_xor(ss, 16); ss += __shfl_xor(ss, 32);
                const float rsc = rsqrtf(ss * (1.f / 128.f) + RMS_EPS) * (1.f - lam_init);
                const size_t m = mrow0 + q0 + 16 * rs + li;
                const GAS bf16* gp = (const GAS bf16*)h + m * NH + C_GC + hh * 128 + 4 * g; GAS bf16* yp = (GAS bf16*)ycat + m * DM + Y_C + hh * 128 + 4 * g; const GAS float* ngp = (const GAS float*)ng + hh * 128 + 4 * g;
#pragma unroll
                for (int blk = 0; blk < 8; ++blk) { const v2u gt = *(const GAS v2u*)(gp + 16 * blk); const pg8::f32x4 nv = *(const GAS pg8::f32x4*)(ngp + 16 * blk);
                    v2u w; w.x = pk2(oacc[blk][0] * rsc * nv[0] * __uint_as_float(gt.x << 16), oacc[blk][1] * rsc * nv[1] * __uint_as_float(gt.x & 0xffff0000u));
                    w.y = pk2(oacc[blk][2] * rsc * nv[2] * __uint_as_float(gt.y << 16), oacc[blk][3] * rsc * nv[3] * __uint_as_float(gt.y & 0xffff0000u));
                    *(GAS v2u*)(yp + 16 * blk) = w; }
            }
            __syncthreads();
        }
    }
}
__device__ __forceinline__ void mix_attn_combine(const bf16* h, const float* atmp, const float* dl, int layer, const float* ng, bf16* ycat, int gw, int ngw, int lane) {
    const float lam = diff_lam(dl, layer), lam_init = 0.8f - 0.6f * expf(-0.3f * (float)layer);
    for (int item = gw; item < MT * 4; item += ngw) {
        const int hh = item & 3, m = item >> 2;
        const float* a1 = atmp + (size_t)m * GW + hh * 128, *a2 = atmp + ((size_t)MT + m) * GW + hh * 128;
        const float o0 = a1[lane] - lam * a2[lane], o1 = a1[64 + lane] - lam * a2[64 + lane];
        const float rs = rsqrtf(wave_sum(o0 * o0 + o1 * o1) * (1.f / 128.f) + RMS_EPS) * (1.f - lam_init);
        const bf16* hr = h + (size_t)m * NH + C_GC + hh * 128; bf16* yr = ycat + (size_t)m * DM + Y_C + hh * 128;
        yr[lane] = (bf16)f2bf(o0 * rs * ng[hh * 128 + lane] * bf1(hr[lane])); yr[64 + lane] = (bf16)f2bf(o1 * rs * ng[hh * 128 + 64 + lane] * bf1(hr[64 + lane]));
    }
}
__device__ __forceinline__ void ln_rows(float* z, const float* g, const float* bta, bf16* xlnb, int gw, int ngw, int lane) {
    for (int m = gw; m < MT; m += ngw) {
        f32x4* zr = (f32x4*)(z + (size_t)m * DM) + lane; f32x4 v[8]; float s = 0.f;
#pragma unroll
        for (int j = 0; j < 8; ++j) { v[j] = zr[64 * j]; s += (v[j][0] + v[j][1]) + (v[j][2] + v[j][3]); }
        const float mean = wave_sum(s) * (1.f / DM); float s2 = 0.f;
#pragma unroll
        for (int j = 0; j < 8; ++j) { v[j] = v[j] - mean; s2 += (v[j][0] * v[j][0] + v[j][1] * v[j][1]) + (v[j][2] * v[j][2] + v[j][3] * v[j][3]); }
        const float rstd = rsqrtf(wave_sum(s2) * (1.f / DM) + LN_EPS);
        v2u* o8 = (v2u*)(xlnb + (size_t)m * DM) + lane;
#pragma unroll
        for (int j = 0; j < 8; ++j) { const f32x4 gg = ((const f32x4*)g)[64 * j + lane], bb = ((const f32x4*)bta)[64 * j + lane]; const f32x4 y = v[j] * rstd * gg + bb;
            zr[64 * j] = y; v2u w; w.x = pk2(y[0], y[1]); w.y = pk2(y[2], y[3]); o8[64 * j] = w; }
    }
}

constexpr int N_PHASES = 1 + DEPTH * 6;
__global__ void __launch_bounds__(512, 2) mk_fwd(Args args) {
    extern __shared__ __attribute__((aligned(16))) unsigned char lds[];
    cg::grid_group grid = cg::this_grid();
    const int G = gridDim.x, wg = blockIdx.x;
    volatile LAS unsigned* MISC = (volatile LAS unsigned*)((LAS unsigned char*)lds + (LDS_BYTES - 64));
    if (threadIdx.x < 16) MISC[threadIdx.x] = 0u;
    __syncthreads();
    XcdBarrier xbar = xcd_barrier_post((unsigned*)args.ws, MISC);
#define TIDS() const int tid = tid_opaque(), lane = tid & 63, wave = __builtin_amdgcn_readfirstlane(tid >> 6); const int gw = wg * 8 + wave, ngw = G * 8, gtid = wg * 512 + tid, gstride = G * 512; (void)lane; (void)gw; (void)ngw; (void)gtid; (void)gstride
#define PTRS() unsigned char* ws = args.ws; asm volatile("" : "+s"(ws)); \
    bf16* WinT = (bf16*)(ws + WS_WIN); bf16* WoutT = (bf16*)(ws + WS_WOUT); bf16* WpgT = (bf16*)(ws + WS_WPG); bf16* WpeT = (bf16*)(ws + WS_WPE); \
    bf16* XB = (bf16*)(ws + WS_XB); bf16* PB = (bf16*)(ws + WS_PB); bf16* PE = (bf16*)(ws + WS_PE); bf16* H = (bf16*)(ws + WS_H); bf16* VT = (bf16*)(ws + WS_VT); \
    bf16* YC = (bf16*)(ws + WS_YCAT); float* Z = (float*)(ws + WS_Z); bf16* XLNB = (bf16*)(ws + WS_XLNB); float* XF = args.out;   float* ATMP = (float*)(ws + WS_ATMP); float* US = (float*)(ws + WS_HS); bf16* SB = (bf16*)(ws + WS_SB); float* DD = (float*)(ws + WS_DD); float* C1 = (float*)(ws + 65536); float* C2 = (float*)(ws + 81920); float* STATS = (float*)(ws + 131072); (void)US; (void)SB; (void)DD; (void)C1; (void)C2; (void)STATS; \
    (void)WinT; (void)WoutT; (void)WpgT; (void)WpeT; (void)XB; (void)PB; (void)PE; (void)H; (void)VT; (void)YC; (void)Z; (void)XLNB; (void)XF; (void)ATMP
    const int lo = args.ph_lo, hi = args.ph_hi;
#define IN(k) (lo <= (k) && (k) < hi)
#define SEAM(k) do { if (IN(k) && IN((k) + 1)) xcd_barrier(xbar); } while (0)
    if (lo < 0) grid.sync();
    constexpr int I_IN = 32 * 120, I_O = 32 * 32, I_PE = 4 * 32, I_L = I_IN + 2 * I_O + I_PE;
#define CONVERT_ITEMS(lo_, hi_) do { TIDS(); PTRS(); float* scr = (float*)(lds + wave * 16640); \
        for (int it = (lo_) + gw; it < (hi_); it += ngw) { const int cl = it / I_L; int r = it % I_L; \
            if (r < I_IN) { p0_transpose_item(args.in[2] + (size_t)cl * DM * NH, DM, NH, WinT + (size_t)cl * NH * DM, scr, r, lane, nullptr, nullptr, nullptr, nullptr); continue; } r -= I_IN; \
            if (r < I_O) { p0_transpose_item(args.in[12] + (size_t)cl * DM * DM, DM, DM, WoutT + (size_t)cl * DM * DM, scr, r, lane, nullptr, nullptr, nullptr, nullptr); continue; } r -= I_O; \
            if (r < I_O) { p0_transpose_item(args.in[16] + (size_t)cl * DM * DM, DM, DM, WpgT + (size_t)cl * DM * DM, scr, r, lane, args.in[13] + cl * DM, args.in[14] + cl * DM, C1 + cl * DM, C2 + cl * DM); continue; } r -= I_O; \
            p0_transpose_item(args.in[15] + (size_t)cl * PLE * DM, PLE, DM, WpeT + (size_t)cl * DM * PLE, scr, r, lane, nullptr, nullptr, nullptr, nullptr); } } while (0)
#define FILL_SEAM(k, lo_, hi_, lo2_, hi2_) do { if (IN(k) && IN((k) + 1)) { if (l == 0 && DEPTH == 2) { xcd_barrier_arrive(xbar); CONVERT_ITEMS(I_L + (lo_), I_L + (hi_)); \
        if ((hi2_) > (lo2_)) CONVERT_ITEMS(I_L + (lo2_), I_L + (hi2_)); xcd_barrier_wait(xbar); } else xcd_barrier(xbar); } } while (0)
    if (IN(0) && !(DIS&128)) { CONVERT_ITEMS(0, I_L); }
    if (IN(0) && !(DIS&128)) { TIDS(); PTRS();
        for (int i0 = gtid; i0 < MT * DM / 4; i0 += 8 * gstride) { f32x4 v[8];
#pragma unroll
            for (int u = 0; u < 8; ++u) { const int i = i0 + u * gstride; if (i < MT * DM / 4) v[u] = ((const f32x4*)args.in[0])[i]; }
#pragma unroll
            for (int u = 0; u < 8; ++u) { const int i = i0 + u * gstride; if (i < MT * DM / 4) { v2u w; w.x = pk2(v[u][0], v[u][1]); w.y = pk2(v[u][2], v[u][3]); ((v2u*)XB)[i] = w; } } }
        for (int i0 = gtid; i0 < DEPTH * MT * PLE / 4; i0 += 8 * gstride) { f32x4 v[8];
#pragma unroll
            for (int u = 0; u < 8; ++u) { const int i = i0 + u * gstride; if (i < DEPTH * MT * PLE / 4) v[u] = ((const f32x4*)args.in[1])[i]; }
#pragma unroll
            for (int u = 0; u < 8; ++u) { const int i = i0 + u * gstride; if (i < DEPTH * MT * PLE / 4) { v2u w; w.x = pk2(v[u][0], v[u][1]); w.y = pk2(v[u][2], v[u][3]); ((v2u*)PB)[i] = w; } } }
    }
    if (IN(0) && IN(1)) { if (DEPTH == 2) { xcd_barrier_arrive(xbar); CONVERT_ITEMS(I_L, I_L + 1280); xcd_barrier_wait(xbar); } else xcd_barrier(xbar); }
#pragma nounroll
    for (int l = 0; l < DEPTH; ++l) {
        const int p1 = 1 + 6 * l;
        if (IN(p1) && !(DIS&64)) { PTRS();
            { pg8::Gemm g{XB, WinT + (size_t)l * NH * DM, MT, NH, DM}; pg8::SkipOrder S; S.init(MT, NH, G, wg, C_CV / 256, 2); pg8::EpiH E{H, NH, 1};
              pg8::gemm_phase<pg8::EpiH, pg8::SkipOrder, true, true>((PG8_LAS unsigned char*)lds, g, S, E); }
            { pg8::Gemm g{WinT + (size_t)l * NH * DM + (size_t)C_CV * DM, XB, GW, MT, DM}; pg8::StaticOrder S; S.init(GW, MT, G, (G == 256) ? (wg + 128) % 256 : wg); pg8::EpiH E{VT, MT, 0};
              pg8::gemm_phase<pg8::EpiH, pg8::StaticOrder, true, true>((PG8_LAS unsigned char*)lds, g, S, E); }
            { pg8::Gemm g{PB + (size_t)l * MT * PLE, WpeT + (size_t)l * DM * PLE, MT, DM, PLE}; pg8::StaticOrder S; if (G == 256) S.init(MT, DM, 64, wg >= 192 ? wg - 192 : (1 << 20)); else S.init(MT, DM, G, wg); pg8::EpiH E{PE, DM, 0};
              pg8::gemm_phase<pg8::EpiH, pg8::StaticOrder, true, true>((PG8_LAS unsigned char*)lds, g, S, E); }
        }
        FILL_SEAM(p1, 1280, 2560, 0, 0);
        if (IN(p1 + 1)) {
            if(!(DIS&1)) { PTRS(); hgrn_pass1(H, args.in[4], l, US, DD, (char*)lds, wg, G); }
            xcd_barrier_arrive(xbar);
            if(!(DIS&8)) { PTRS(); mix_attn(H, VT, args.in[6] + l * 256, l, args.in[7] + l * GW, YC, (char*)lds, wg, G); }
            xcd_barrier_wait(xbar);
            { TIDS(); PTRS(); hgrn_scan(US, DD, SB, gtid, gstride); }
            xcd_barrier_arrive(xbar);
            if(!(DIS&2)) { PTRS(); mix_sgu(H, args.in[8] + l * GW, args.in[9] + l * GW, args.in[10] + (size_t)l * 4 * 16384, args.in[11] + l * GW, YC, (char*)lds, wg, G); }
            if(!(DIS&4)) { TIDS(); PTRS(); mix_conv(H, args.in[3] + l * 3 * GW, YC, gtid, gstride); }
            xcd_barrier_wait(xbar);
        }
        if (IN(p1 + 3)) { PTRS(); hgrn_pass3(H, args.in[4], l, SB, args.in[5] + l * GW, YC, (char*)lds, wg, G); }
        FILL_SEAM(p1 + 3, 2560, I_IN, I_IN + 2 * I_O, I_L);
        if (IN(p1 + 4) && !(DIS&16)) { PTRS(); const float* xres = (l == 0) ? args.in[0] : XF; asm volatile("" : "+s"(xres));
            pg8::Gemm g{YC, WoutT + (size_t)l * DM * DM, MT, DM, DM}; pg8::StaticOrder S; S.init(MT, DM, G, wg); pg8::EpiZ E{xres, Z, XLNB, STATS + (size_t)l * MT * 2, DM, ALPHA};
            pg8::gemm_phase<pg8::EpiZ, pg8::StaticOrder, true, true>((PG8_LAS unsigned char*)lds, g, S, E);
        }
        FILL_SEAM(p1 + 4, I_IN, I_IN + I_O, 0, 0);
        if (IN(p1 + 5) && !(DIS&32)) { PTRS(); float* xout = (l == DEPTH - 1) ? args.out : XF; asm volatile("" : "+s"(xout));
            pg8::Gemm g{XLNB, WpgT + (size_t)l * DM * DM, MT, DM, DM}; pg8::StaticOrder S; S.init(MT, DM, G, wg); pg8::EpiPG E{XLNB, STATS + (size_t)l * MT * 2, C1 + l * DM, C2 + l * DM, args.in[13] + l * DM, args.in[14] + l * DM, PE, xout, (l == DEPTH - 1) ? (bf16*)nullptr : XB, DM};
            pg8::gemm_phase<pg8::EpiPG, pg8::StaticOrder, true, true>((PG8_LAS unsigned char*)lds, g, S, E);
        }
        if (l + 1 < DEPTH) FILL_SEAM(p1 + 5, I_IN + I_O, I_IN + 2 * I_O, 0, 0);
    }
#undef IN
#undef SEAM
}

extern "C" void kernel_launch(void* const* d_in, const int* in_sizes, int n_in, void* d_out, int out_size, void* d_ws, size_t ws_size, hipStream_t stream) {
    static int grid = 0;
    if (grid == 0) {
        if (n_in != 17 || out_size != MT * DM || ws_size < WS_END) { fprintf(stderr, "kernel_launch: unexpected shapes (n_in %d, out %d, ws %zu)\n", n_in, out_size, ws_size); grid = -1; return; }
        int dev = 0, cus = 0, per_cu = 0;
        hipGetDevice(&dev); hipDeviceGetAttribute(&cus, hipDeviceAttributeMultiprocessorCount, dev);
        hipFuncSetAttribute((const void*)mk_fwd, hipFuncAttributeMaxDynamicSharedMemorySize, LDS_BYTES);
        hipOccupancyMaxActiveBlocksPerMultiprocessor(&per_cu, (const void*)mk_fwd, 512, LDS_BYTES);
        if (per_cu < 1) { fprintf(stderr, "kernel_launch: occupancy query returned %d\n", per_cu); per_cu = 1; }
        (void)hipGetLastError();
        grid = cus * per_cu;
        fprintf(stderr, "kernel_launch: grid %d (cus %d x %d)\n", grid, cus, per_cu);
    }
    if (grid < 0) return;
    if (hipMemsetAsync(d_ws, 0, 262144, stream) != hipSuccess) { fprintf(stderr, "kernel_launch: memset failed\n"); return; }
    Args a{};
    for (int i = 0; i < 17; ++i) a.in[i] = (const float*)d_in[i];
    a.out = (float*)d_out; a.ws = (unsigned char*)d_ws;
#if MK_PER_PHASE
    for (int p = 0; p < N_PHASES; ++p) { a.ph_lo = p; a.ph_hi = p + 1; void* kargs[] = {&a};
        hipError_t e = hipLaunchCooperativeKernel((const void*)mk_fwd, dim3(grid), dim3(512), kargs, LDS_BYTES, stream);
        if (e != hipSuccess) { fprintf(stderr, "launch %d failed: %s\n", p, hipGetErrorString(e)); break; } }
#else
    a.ph_lo = 0; a.ph_hi = N_PHASES; void* kargs[] = {&a};
    hipError_t e = hipLaunchCooperativeKernel((const void*)mk_fwd, dim3(grid), dim3(512), kargs, LDS_BYTES, stream);
    if (e != hipSuccess) fprintf(stderr, "cooperative launch failed: %s (grid %d)\n", hipGetErrorString(e), grid);
#endif
}
```
